# Optimizing an MI355X kernel written in HIP

```python
import math
import jax, jax.numpy as jnp
from jax import lax
import numpy as np

D_MODEL = 1024
BATCH = 4
SEQ = 8192
DEPTH = 1

HEAD_DIM = 64
A_HEADS = D_MODEL // (2 * HEAD_DIM)
A_KV_HEADS = 2
A_GROUP = A_HEADS // A_KV_HEADS
A_WIDTH = A_HEADS * HEAD_DIM
A_KV_WIDTH = A_KV_HEADS * HEAD_DIM
WINDOW = 128
B_HEADS = D_MODEL // (2 * HEAD_DIM)
B_WIDTH = B_HEADS * HEAD_DIM
MOBA_BLOCK = 256
MOBA_TOPK = 3
MOBA_CHUNK = 64
N_BUCKETS = 32
MAX_DISTANCE = 128
DN_ALPHA = (2.0 * DEPTH) ** 0.25
DN_BETA = (8.0 * DEPTH) ** -0.25
LN_EPS = 1e-5
NEG = -1e30
ATTN_SCALE = HEAD_DIM ** -0.5

IN_SIZES = (A_WIDTH, A_KV_WIDTH, A_KV_WIDTH, A_WIDTH,
            B_WIDTH, B_WIDTH, B_WIDTH, B_WIDTH,
            D_MODEL, D_MODEL)
IN_TOTAL = sum(IN_SIZES)

kernel_name = "hybrid_swa_sink_moba_gated_deepnorm"


def _split_cols(h):
    parts, start = [], 0
    for size in IN_SIZES:
        parts.append(h[..., start:start + size])
        start += size
    return parts


def t5_bucket(dist):
    max_exact = N_BUCKETS // 2
    n = jnp.maximum(dist, 0)
    nf = jnp.maximum(n, 1).astype(jnp.float32)
    large = max_exact + (jnp.log(nf / max_exact) / math.log(MAX_DISTANCE / max_exact)
                         * (N_BUCKETS - max_exact)).astype(jnp.int32)
    large = jnp.minimum(large, N_BUCKETS - 1)
    return jnp.where(n < max_exact, n, large)


def layer_norm(x, g, b):
    xf = x.astype(jnp.float32)
    mu = jnp.mean(xf, axis=-1, keepdims=True)
    var = jnp.mean(jnp.square(xf - mu), axis=-1, keepdims=True)
    return ((xf - mu) * lax.rsqrt(var + LN_EPS) * g.astype(jnp.float32)
            + b.astype(jnp.float32)).astype(x.dtype)


def swa_sink_attention(q, k, v, sinks, rel_table):
    B_, S_, _ = q.shape
    nb = S_ // WINDOW
    qb = q.reshape(B_, nb, WINDOW, A_KV_HEADS, A_GROUP, HEAD_DIM)
    kb = k.reshape(B_, nb, WINDOW, A_KV_HEADS, HEAD_DIM)
    vb = v.reshape(B_, nb, WINDOW, A_KV_HEADS, HEAD_DIM)
    pad = jnp.zeros_like(kb[:, :1])
    k2 = jnp.concatenate([jnp.concatenate([pad, kb[:, :-1]], axis=1), kb], axis=2)
    v2 = jnp.concatenate([jnp.concatenate([pad, vb[:, :-1]], axis=1), vb], axis=2)
    logits = jnp.einsum('bnqkgd,bnskd->bnkgqs', qb, k2,
                        preferred_element_type=jnp.float32) * ATTN_SCALE
    i = jnp.arange(WINDOW)[:, None]
    j = jnp.arange(2 * WINDOW)[None, :]
    dist = WINDOW + i - j
    bias = rel_table.astype(jnp.float32)[t5_bucket(dist)]
    bias = bias.transpose(2, 0, 1).reshape(A_KV_HEADS, A_GROUP, WINDOW, 2 * WINDOW)
    valid = (dist >= 0) & (dist < WINDOW)
    first = (jnp.arange(nb) == 0)[:, None, None] & (j < WINDOW)[None]
    mask = valid[None] & ~first
    logits = jnp.where(mask[None, :, None, None], logits + bias[None, None], NEG)
    sink = jnp.broadcast_to(sinks.astype(jnp.float32).reshape(A_KV_HEADS, A_GROUP)[None, None, :, :, None, None],
                            logits.shape[:-1] + (1,))
    p = jax.nn.softmax(jnp.concatenate([logits, sink], axis=-1), axis=-1)[..., :-1]
    o = jnp.einsum('bnkgqs,bnskd->bnqkgd', p.astype(v.dtype), v2)
    return o.reshape(B_, S_, A_WIDTH)


def moba_attention(q, k, v, rel_table):
    B_, S_, _ = q.shape
    s_pad = -(-S_ // MOBA_BLOCK) * MOBA_BLOCK
    padw = ((0, 0), (0, s_pad - S_), (0, 0))
    q, k, v = [jnp.pad(t, padw).reshape(B_, s_pad, B_HEADS, HEAD_DIM).transpose(0, 2, 1, 3)
               for t in (q, k, v)]
    nblk = s_pad // MOBA_BLOCK
    k_eff = min(MOBA_TOPK, nblk)
    kblk = k.reshape(B_, B_HEADS, nblk, MOBA_BLOCK, HEAD_DIM)
    vblk = v.reshape(B_, B_HEADS, nblk, MOBA_BLOCK, HEAD_DIM)
    kmean = jnp.mean(kblk.astype(jnp.float32), axis=3)
    gate = jnp.einsum('bhtd,bhnd->bhtn', q.astype(jnp.float32), kmean)
    q_blk = jnp.arange(s_pad) // MOBA_BLOCK
    past = jnp.arange(nblk)[None, :] < q_blk[:, None]
    gate = jnp.where(past, gate, NEG)
    _, sel = lax.top_k(gate, k_eff)
    n_chunks = s_pad // MOBA_CHUNK
    qc = q.reshape(B_, B_HEADS, n_chunks, MOBA_CHUNK, HEAD_DIM).transpose(2, 0, 1, 3, 4)
    selc = sel.reshape(B_, B_HEADS, n_chunks, MOBA_CHUNK, k_eff).transpose(2, 0, 1, 3, 4)
    bi = jnp.arange(B_)[:, None, None, None]
    hi = jnp.arange(B_HEADS)[None, :, None, None]
    hi5 = jnp.arange(B_HEADS)[None, :, None, None, None]
    table_t = rel_table.astype(jnp.float32).T
    blk_ar = jnp.arange(MOBA_BLOCK)

    def chunk_fn(args):
        c, q_c, sel_c = args
        t = c * MOBA_CHUNK + jnp.arange(MOBA_CHUNK)
        own = t[0] // MOBA_BLOCK
        k_own = lax.dynamic_index_in_dim(kblk, own, axis=2, keepdims=False)
        v_own = lax.dynamic_index_in_dim(vblk, own, axis=2, keepdims=False)
        k_sel = kblk[bi, hi, sel_c]
        v_sel = vblk[bi, hi, sel_c]
        d_own = t[:, None] - (own * MOBA_BLOCK + blk_ar)[None, :]
        l_own = (jnp.einsum('bhcd,bhsd->bhcs', q_c, k_own, preferred_element_type=jnp.float32) * ATTN_SCALE
                 + table_t[:, t5_bucket(d_own)][None])
        l_own = jnp.where(d_own >= 0, l_own, NEG)
        d_sel = t[None, None, :, None, None] - (sel_c[..., None] * MOBA_BLOCK + blk_ar)
        l_sel = (jnp.einsum('bhcd,bhcksd->bhcks', q_c, k_sel, preferred_element_type=jnp.float32) * ATTN_SCALE
                 + table_t[hi5, t5_bucket(d_sel)])
        valid_sel = jnp.arange(k_eff)[None, :] < (t // MOBA_BLOCK)[:, None]
        l_sel = jnp.where(valid_sel[:, :, None], l_sel, NEG)
        B2, H2, C2 = q_c.shape[:3]
        logits = jnp.concatenate([l_own, l_sel.reshape(B2, H2, C2, k_eff * MOBA_BLOCK)], axis=-1)
        p = jax.nn.softmax(logits, axis=-1).astype(v.dtype)
        p_own = p[..., :MOBA_BLOCK]
        p_sel = p[..., MOBA_BLOCK:].reshape(B2, H2, C2, k_eff, MOBA_BLOCK)
        return (jnp.einsum('bhcs,bhsd->bhcd', p_own, v_own)
                + jnp.einsum('bhcks,bhcksd->bhcd', p_sel, v_sel))

    out = lax.map(chunk_fn, (jnp.arange(n_chunks), qc, selc))
    out = out.transpose(1, 0, 3, 2, 4).reshape(B_, s_pad, B_WIDTH)
    return out[:, :S_]


def setup_inputs(seed: int = 0) -> dict:
    key = jax.random.key(seed)
    ks = jax.random.split(key, 20)
    x = jax.random.normal(ks[0], (BATCH, SEQ, D_MODEL), jnp.float32)
    col_scale = (1.0, 1.0, DN_BETA, 1.0, 1.0, 1.0, DN_BETA, 1.0, 1.0, 1.0)
    blocks = [jax.random.normal(ks[1 + i], (DEPTH, D_MODEL, n), jnp.float32) * (D_MODEL ** -0.5 * s)
              for i, (n, s) in enumerate(zip(IN_SIZES, col_scale))]
    w_in = jnp.concatenate(blocks, axis=-1)
    b_gate = 0.1 * jax.random.normal(ks[11], (DEPTH, 2 * D_MODEL), jnp.float32)
    sinks = 0.5 * jax.random.normal(ks[12], (DEPTH, A_HEADS), jnp.float32)
    rel_table = 0.5 * jax.random.normal(ks[13], (N_BUCKETS, A_HEADS + B_HEADS), jnp.float32)
    w_out_a = jax.random.normal(ks[14], (DEPTH, A_WIDTH, D_MODEL), jnp.float32) * (A_WIDTH ** -0.5 * DN_BETA)
    w_out_b = jax.random.normal(ks[15], (DEPTH, B_WIDTH, D_MODEL), jnp.float32) * (B_WIDTH ** -0.5 * DN_BETA)
    w_out = jax.random.normal(ks[16], (DEPTH, D_MODEL, D_MODEL), jnp.float32) * (D_MODEL ** -0.5 * DN_BETA)
    ln_gamma = 1.0 + 0.01 * jax.random.normal(ks[17], (DEPTH, D_MODEL), jnp.float32)
    ln_beta = 0.01 * jax.random.normal(ks[18], (DEPTH, D_MODEL), jnp.float32)
    return {"x": x, "w_in": w_in, "b_gate": b_gate, "sinks": sinks, "rel_table": rel_table,
            "w_out_a": w_out_a, "w_out_b": w_out_b, "w_out": w_out,
            "ln_gamma": ln_gamma, "ln_beta": ln_beta}


def reference(x, w_in, b_gate, sinks, rel_table, w_out_a, w_out_b, w_out, ln_gamma, ln_beta):
    table_a = rel_table[:, :A_HEADS]
    table_b = rel_table[:, A_HEADS:]
    for l in range(DEPTH):
        h = jnp.einsum('bsd,de->bse', x, w_in[l])
        qa, ka, va, za, qb, kb, vb, zb, ga, gb = _split_cols(h)
        ya = swa_sink_attention(qa, ka, va, sinks[l], table_a) * jax.nn.silu(za)
        yb = moba_attention(qb, kb, vb, table_b) * jax.nn.silu(zb)
        ya = jnp.einsum('bse,ed->bsd', ya, w_out_a[l])
        yb = jnp.einsum('bse,ed->bsd', yb, w_out_b[l])
        gate_a = jax.nn.sigmoid(ga + b_gate[l, :D_MODEL])
        gate_b = jax.nn.sigmoid(gb + b_gate[l, D_MODEL:])
        merged = gate_a * ya + gate_b * yb
        out = jnp.einsum('bsd,de->bse', merged, w_out[l])
        x = layer_norm(DN_ALPHA * x + out, ln_gamma[l], ln_beta[l])
    return x
```

```cpp
#include <hip/hip_runtime.h>
#include <cstdio>
#include <cstdint>

constexpr int BATCH = 4, SEQ = 8192, DM = 1024, MTOK = BATCH * SEQ, NIN = 5376;
constexpr int QKZ_LD = 2688, G_LD = 2048;
constexpr int QA_OFF = 0, KA_OFF = 512, ZA_OFF = 640, QB_OFF = 1152, KB_OFF = 1664, ZB_OFF = 2176;
constexpr int NVH = 10;
constexpr float LOG2E = 1.4426950408889634f;
constexpr float QS = 0.125f * LOG2E;
constexpr float DN_ALPHA = 1.189207115002721f;
constexpr float LN_EPS = 1e-5f;

namespace pg8 {
#define PG8_LAS __attribute__((address_space(3)))
typedef unsigned short bf16_t;
typedef short bf16x8 __attribute__((ext_vector_type(8)));
typedef float f32x4 __attribute__((ext_vector_type(4)));
typedef unsigned u32x4 __attribute__((ext_vector_type(4)));
constexpr int BM = 256, BK = 64, HALF = 128, HTB = HALF * BK * 2  , STAGE_BYTES = 8 * HTB, NXCD = 8, WGM = 8;

__host__ __device__ __forceinline__ int lds_byte(int r, int c) { const int st = (r >> 4) * 2 + (c >> 5), rr = r & 15, cc = c & 31, ob = rr * 64 + cc * 2; return st * 1024 + (ob ^ (((ob >> 9) & 1) << 5)); }
__host__ __device__ __forceinline__ void stage_rc(int b, int& R, int& C) { const int st = b / 1024, sb = b % 1024, swz = sb ^ (((sb >> 9) & 1) << 5); R = (st >> 1) * 16 + swz / 64; C = (st & 1) * 32 + (swz % 64) / 2; }
__host__ __device__ __forceinline__ int perm32(int rho) { const int n = rho >> 4, i = rho & 15; return 8 * (i >> 2) + 4 * n + (i & 3); }

struct Unit { int pm, pn; };
struct Gemm { const bf16_t* A; const bf16_t* A2; const bf16_t* Bt; int M, N, K; };

struct StaticOrder {
    int nM, nN, nwg, G, c;
    __host__ __device__ void init(int M, int N, int G_, int c_) { nM = M / BM; nN = N / BM; nwg = nM * nN; G = G_; c = c_; }
    __host__ __device__ bool next(int i, Unit& u) const {
        const long L = (long)i * G + c; if (L >= nwg) return false;
        int wgid = (int)L; { const int q = nwg / NXCD, r = nwg % NXCD, xcd = wgid % NXCD, off = wgid / NXCD; wgid = (xcd < r ? xcd * (q + 1) : r * (q + 1) + (xcd - r) * q) + off; }
        const int nig = WGM * nN, gid = wgid / nig, fm = gid * WGM, gsz = (nM - fm) < WGM ? (nM - fm) : WGM;
        u.pm = fm + ((wgid % nig) % gsz); u.pn = (wgid % nig) / gsz; return true;
    }
    __device__ __forceinline__ const char* aptr(const Gemm& g, const Unit& u, size_t tstep) const { return (const char*)g.A + (size_t)u.pm * tstep; }
    __device__ __forceinline__ const char* bptr(const Gemm& g, const Unit& u, size_t tstep) const { return (const char*)g.Bt + (size_t)u.pn * tstep; }
    __device__ __forceinline__ void a_ready(const Unit&) const {}
    __device__ __forceinline__ void done(const Unit&) const {}
};

__device__ __forceinline__ unsigned cvt_pk_bf16(float lo, float hi) { unsigned r; asm volatile("v_cvt_pk_bf16_f32 %0, %1, %2" : "=v"(r) : "v"(lo), "v"(hi)); return r; }
typedef float f32x2 __attribute__((ext_vector_type(2)));

__device__ __forceinline__ float bf_lo(unsigned w) { return __uint_as_float(w << 16); }
__device__ __forceinline__ float bf_hi(unsigned w) { return __uint_as_float(w & 0xffff0000u); }
__device__ __forceinline__ float sigmoidf_(float x) { return __builtin_amdgcn_rcpf(1.0f + __builtin_amdgcn_exp2f(-x * 1.4426950408889634f)); }

struct Epi1 {
    static constexpr bool PERM = true, AFTER_DRAIN = false;
    bf16_t* QKZ; bf16_t* G; bf16_t* VT; float* kpart; const float* bgate;
    __device__ __forceinline__ void operator()(const f32x4 (&acc)[2][2][4][2], const Unit& u, int wr, int wc, int fr, int fq) const {
        const int row0 = u.pm * 256 + wr * 64 + fr;
        const int cl = wc * 32 + 8 * fq;
#pragma unroll
        for (int bj = 0; bj < 2; ++bj) {
            const int cb = u.pn * 256 + bj * 128;
            int mode, dcol;
            if (cb < 512) { mode = 0; dcol = cb; }
            else if (cb < 640) { mode = 1; dcol = cb; }
            else if (cb < 768) { mode = 2; dcol = cb - 640; }
            else if (cb < 1280) { mode = 3; dcol = cb - 128; }
            else if (cb < 1792) { mode = 0; dcol = cb - 128; }
            else if (cb < 2304) { mode = 1; dcol = cb - 128; }
            else if (cb < 2816) { mode = 2; dcol = cb - 2304 + 128; }
            else if (cb < 3328) { mode = 3; dcol = cb - 640; }
            else { mode = 4; dcol = cb - 3328; }
            if (mode == 2) {
                const int b = u.pm >> 5, t0 = (u.pm & 31) * 256 + wr * 64 + fr, dc = dcol + cl, vh = dc >> 6, d0 = dc & 63;
                bf16_t* p = VT + ((size_t)(b * 10 + vh) * 64 + d0) * 8192 + t0;
#pragma unroll
                for (int ai = 0; ai < 2; ++ai)
#pragma unroll
                    for (int m = 0; m < 4; ++m)
#pragma unroll
                        for (int n = 0; n < 2; ++n) { const f32x4 v = acc[ai][bj][m][n]; const unsigned w0 = cvt_pk_bf16(v[0], v[1]), w1 = cvt_pk_bf16(v[2], v[3]);
                            bf16_t* q = p + (size_t)(4 * n) * 8192 + ai * 128 + m * 16;
                            q[0] = (bf16_t)(w0 & 0xffffu); q[8192] = (bf16_t)(w0 >> 16); q[2 * 8192] = (bf16_t)(w1 & 0xffffu); q[3 * 8192] = (bf16_t)(w1 >> 16); }
            } else if (mode == 4) {
                const f32x4 b0 = *(const f32x4*)(bgate + dcol + cl), b1 = *(const f32x4*)(bgate + dcol + cl + 4);
#pragma unroll
                for (int ai = 0; ai < 2; ++ai)
#pragma unroll
                    for (int m = 0; m < 4; ++m) { f32x4 v0 = acc[ai][bj][m][0] + b0, v1 = acc[ai][bj][m][1] + b1;
#pragma unroll
                        for (int i = 0; i < 4; ++i) { v0[i] = sigmoidf_(v0[i]); v1[i] = sigmoidf_(v1[i]); }
                        u32x4 w; w.x = cvt_pk_bf16(v0[0], v0[1]); w.y = cvt_pk_bf16(v0[2], v0[3]); w.z = cvt_pk_bf16(v1[0], v1[1]); w.w = cvt_pk_bf16(v1[2], v1[3]);
                        *(u32x4*)(G + (size_t)(row0 + ai * 128 + m * 16) * 2048 + dcol + cl) = w; }
            } else {
#pragma unroll
                for (int ai = 0; ai < 2; ++ai)
#pragma unroll
                    for (int m = 0; m < 4; ++m) { f32x4 v0 = acc[ai][bj][m][0], v1 = acc[ai][bj][m][1];
                        if (mode == 0) { v0 = v0 * (0.125f * 1.4426950408889634f); v1 = v1 * (0.125f * 1.4426950408889634f); }
                        else if (mode == 3) {
#pragma unroll
                            for (int i = 0; i < 4; ++i) { v0[i] = v0[i] * sigmoidf_(v0[i]); v1[i] = v1[i] * sigmoidf_(v1[i]); } }
                        u32x4 w; w.x = cvt_pk_bf16(v0[0], v0[1]); w.y = cvt_pk_bf16(v0[2], v0[3]); w.z = cvt_pk_bf16(v1[0], v1[1]); w.w = cvt_pk_bf16(v1[2], v1[3]);
                        *(u32x4*)(QKZ + (size_t)(row0 + ai * 128 + m * 16) * 2688 + dcol + cl) = w; }
                if (cb >= 1792 && cb < 2304) {
                    float s[8];
#pragma unroll
                    for (int n = 0; n < 2; ++n)
#pragma unroll
                        for (int i = 0; i < 4; ++i) { float t = 0.f;
#pragma unroll
                            for (int ai = 0; ai < 2; ++ai)
#pragma unroll
                                for (int m = 0; m < 4; ++m) t += acc[ai][bj][m][n][i];
                            t += __shfl_xor(t, 1); t += __shfl_xor(t, 2); t += __shfl_xor(t, 4); t += __shfl_xor(t, 8); s[4 * n + i] = t; }
                    if (fr == 0) { float* kp = kpart + (size_t)(u.pm * 2 + wr) * 512 + (cb - 1792) + cl;
                        *(f32x4*)kp = (f32x4){s[0], s[1], s[2], s[3]}; *(f32x4*)(kp + 4) = (f32x4){s[4], s[5], s[6], s[7]}; }
                }
            }
        }
    }
};

struct EpiOut {
    static constexpr bool PERM = true, AFTER_DRAIN = false;
    const bf16_t* G; float* T; bf16_t* MRG;
    __device__ __forceinline__ void operator()(const f32x4 (&acc)[2][2][4][2], const Unit& u, int wr, int wc, int fr, int fq) const {
        const int half = u.pn >> 2, pnc = u.pn & 3, row0 = u.pm * 256 + wr * 64 + fr;
#pragma unroll
        for (int bj = 0; bj < 2; ++bj) { const int c0 = pnc * 256 + bj * 128 + wc * 32 + 8 * fq;
#pragma unroll
            for (int ai = 0; ai < 2; ++ai)
#pragma unroll
                for (int m = 0; m < 4; ++m) { const size_t row = (size_t)(row0 + ai * 128 + m * 16);
                    const u32x4 gw = *(const u32x4*)(G + row * 2048 + half * 1024 + c0);
                    f32x4 v0 = acc[ai][bj][m][0] * (f32x4){bf_lo(gw.x), bf_hi(gw.x), bf_lo(gw.y), bf_hi(gw.y)};
                    f32x4 v1 = acc[ai][bj][m][1] * (f32x4){bf_lo(gw.z), bf_hi(gw.z), bf_lo(gw.w), bf_hi(gw.w)};
#if defined(DIAG) && (DIAG & 1)
                    if (half == 0) { v0 = v0 * 0.f; v1 = v1 * 0.f; }
#endif
#if defined(DIAG) && (DIAG & 2)
                    if (half == 1) { v0 = v0 * 0.f; v1 = v1 * 0.f; }
#endif
                    float* tp = T + row * 1024 + c0;
                    if (half == 0) { *(f32x4*)tp = v0; *(f32x4*)(tp + 4) = v1; }
                    else { v0 += *(const f32x4*)tp; v1 += *(const f32x4*)(tp + 4);
                        u32x4 w; w.x = cvt_pk_bf16(v0[0], v0[1]); w.y = cvt_pk_bf16(v0[2], v0[3]); w.z = cvt_pk_bf16(v1[0], v1[1]); w.w = cvt_pk_bf16(v1[2], v1[3]);
                        *(u32x4*)(MRG + row * 1024 + c0) = w; } } }
    }
};

struct EpiRes {
    static constexpr bool PERM = false, AFTER_DRAIN = false;
    const float* x; float* out;
    __device__ __forceinline__ void operator()(const f32x4 (&acc)[2][2][4][2], const Unit& u, int wr, int wc, int fr, int fq) const {
        const int row0 = u.pm * 256 + wr * 64 + fr, col0 = u.pn * 256 + wc * 32 + 4 * fq;
#pragma unroll
        for (int ai = 0; ai < 2; ++ai)
#pragma unroll
            for (int m = 0; m < 4; ++m) { const size_t off = (size_t)(row0 + ai * 128 + m * 16) * 1024 + col0;
#pragma unroll
                for (int bj = 0; bj < 2; ++bj)
#pragma unroll
                    for (int n = 0; n < 2; ++n) { const f32x4 xv = *(const f32x4*)(x + off + bj * 128 + n * 16);
                        *(f32x4*)(out + off + bj * 128 + n * 16) = xv * 1.189207115002721f + acc[ai][bj][m][n]; } }
    }
};

struct OrderOut {
    int vcu, G;
    __device__ __forceinline__ bool next(int i, Unit& u) const { const int tile = vcu + G * (i >> 1); if (tile >= 512) return false; u.pm = tile >> 2; u.pn = (tile & 3) + 4 * (i & 1); return true; }
    __device__ __forceinline__ const char* aptr(const Gemm& g, const Unit& u, size_t tstep) const { return (const char*)(u.pn >= 4 ? g.A2 : g.A) + (size_t)u.pm * tstep; }
    __device__ __forceinline__ const char* bptr(const Gemm& g, const Unit& u, size_t tstep) const { return (const char*)g.Bt + (size_t)u.pn * tstep; }
    __device__ __forceinline__ void a_ready(const Unit&) const {}
    __device__ __forceinline__ void done(const Unit&) const {}
};
struct OrderRes {
    int vcu, G;
    __device__ __forceinline__ bool next(int i, Unit& u) const { const int tile = vcu + G * i; if (tile >= 512) return false; u.pm = tile >> 2; u.pn = tile & 3; return true; }
    __device__ __forceinline__ const char* aptr(const Gemm& g, const Unit& u, size_t tstep) const { return (const char*)g.A + (size_t)u.pm * tstep; }
    __device__ __forceinline__ const char* bptr(const Gemm& g, const Unit& u, size_t tstep) const { return (const char*)g.Bt + (size_t)u.pn * tstep; }
    __device__ __forceinline__ void a_ready(const Unit&) const {}
    __device__ __forceinline__ void done(const Unit&) const {}
};

template <class Epi, class Sched, bool ALIGN_EPI = false, bool SP2 = false>
__device__ __forceinline__ void gemm_phase(PG8_LAS unsigned char* lds, const Gemm g, const Sched& S, const Epi& E) {
    const int tid = threadIdx.x, wid = __builtin_amdgcn_readfirstlane(tid >> 6), lane = tid & 63, wr = wid >> 2, wc = wid & 3, fr = lane & 15, fq = lane >> 4;
    const int K = g.K, nt = K / BK;
    unsigned voffA[2], voffB[2];
#pragma unroll
    for (int i = 0; i < 2; ++i) { int R, C; stage_rc(tid * 16 + i * 8192, R, C); const int Rb = Epi::PERM ? ((R & ~31) + perm32(R & 31)) : R;
        voffA[i] = (unsigned)(R * K + C) * 2u; voffB[i] = (unsigned)(Rb * K + C) * 2u; }
    const size_t kstep = (size_t)(BK * 2);
    const size_t hstep = (size_t)HALF * K * 2;
    const size_t tstep = 2 * hstep;
    const unsigned ldsw = (unsigned)wid * 1024u;
    const int aoff = lds_byte(wr * 64 + fr, fq * 8), boff = lds_byte(wc * 32 + fr, fq * 8);
#define PG8_SA(b, h) (((b) * 2 + (h)) * HTB)
#define PG8_SB(b, h) ((4 + (b) * 2 + (h)) * HTB)
#define PG8_STAGE(bufoff, gbase, voff) do { _Pragma("unroll") for (int _i = 0; _i < 2; ++_i) \
        __builtin_amdgcn_global_load_lds((const unsigned*)((const char*)(gbase) + (voff)[_i]), (PG8_LAS unsigned*)(lds + (bufoff) + ldsw + _i * 8192), 16, 0, 0); } while (0)
#define PG8_LDA(dst, b, h) do { _Pragma("unroll") for (int m = 0; m < 4; ++m) _Pragma("unroll") for (int k = 0; k < 2; ++k) dst[m][k] = *(const PG8_LAS bf16x8*)(lds + PG8_SA(b, h) + aoff + m * 2048 + k * 1024); } while (0)
#define PG8_LDB(dst, b, h) do { _Pragma("unroll") for (int n = 0; n < 2; ++n) _Pragma("unroll") for (int k = 0; k < 2; ++k) dst[n][k] = *(const PG8_LAS bf16x8*)(lds + PG8_SB(b, h) + boff + n * 2048 + k * 1024); } while (0)
#define PG8_MMA(ai, bj, At, Bt) do { __builtin_amdgcn_s_setprio(1); _Pragma("unroll") for (int m = 0; m < 4; ++m) _Pragma("unroll") for (int n = 0; n < 2; ++n) _Pragma("unroll") for (int k = 0; k < 2; ++k) \
        acc[ai][bj][m][n] = __builtin_amdgcn_mfma_f32_16x16x32_bf16(Bt[n][k], At[m][k], acc[ai][bj][m][n], 0, 0, 0); __builtin_amdgcn_s_setprio(0); } while (0)
#define PG8_WAIT_V(n) asm volatile("s_waitcnt vmcnt(" #n ")" ::: "memory")
#define PG8_WAIT_L(n) asm volatile("s_waitcnt lgkmcnt(" #n ")" ::: "memory")
#define PG8_BAR __builtin_amdgcn_s_barrier()
#define PG8_SCHED __builtin_amdgcn_sched_barrier(0)
    Unit cur, nxt; int ui = 0;
    if (!S.next(0, cur)) return;
    f32x4 acc[2][2][4][2];
#pragma unroll
    for (int a = 0; a < 2; ++a)
#pragma unroll
        for (int b = 0; b < 2; ++b)
#pragma unroll
            for (int m = 0; m < 4; ++m)
#pragma unroll
                for (int n = 0; n < 2; ++n) acc[a][b][m][n] = (f32x4){0.f, 0.f, 0.f, 0.f};
    bf16x8 At[4][2], B0[2][2], B1[2][2];
    const char* cA = S.aptr(g, cur, tstep); const char* cB = S.bptr(g, cur, tstep);
    S.a_ready(cur);
    if constexpr (SP2) {
        PG8_STAGE(PG8_SB(0, 0), cB, voffB); PG8_STAGE(PG8_SB(0, 1), cB + hstep, voffB); PG8_STAGE(PG8_SA(0, 0), cA, voffA); PG8_STAGE(PG8_SA(0, 1), cA + hstep, voffA);
        if (wr == 1) PG8_BAR;
        PG8_WAIT_V(2); PG8_BAR;
        PG8_STAGE(PG8_SB(1, 0), cB + kstep, voffB); PG8_STAGE(PG8_SA(1, 0), cA + kstep, voffA); PG8_STAGE(PG8_SB(1, 1), cB + hstep + kstep, voffB);
        PG8_WAIT_V(6); PG8_BAR;
    } else {
        PG8_STAGE(PG8_SB(0, 0), cB, voffB); PG8_STAGE(PG8_SA(0, 0), cA, voffA); PG8_STAGE(PG8_SB(0, 1), cB + hstep, voffB); PG8_STAGE(PG8_SA(0, 1), cA + hstep, voffA);
        if (wr == 1) PG8_BAR;
        PG8_WAIT_V(4); PG8_BAR;
        PG8_STAGE(PG8_SB(1, 0), cB + kstep, voffB); PG8_STAGE(PG8_SA(1, 0), cA + kstep, voffA); PG8_STAGE(PG8_SB(1, 1), cB + hstep + kstep, voffB);
        PG8_WAIT_V(6); PG8_BAR;
    }
    for (;;) {
        const bool has_next = S.next(ui + 1, nxt);
        const char* nA = has_next ? S.aptr(g, nxt, tstep) : cA; const char* nB = has_next ? S.bptr(g, nxt, tstep) : cB;
        for (int t = 0; t < nt; t += 2) {
            const bool last = (t == nt - 2);
            const char* a1 = cA + (size_t)(t + 1) * kstep;
            const char* a2 = last ? nA : cA + (size_t)(t + 2) * kstep; const char* b2 = last ? nB : cB + (size_t)(t + 2) * kstep;
            const char* a3 = a2 + kstep; const char* b3 = b2 + kstep;
            if (last && has_next) S.a_ready(nxt);
            if constexpr (SP2) {
            PG8_LDB(B0, 0, 0); PG8_LDB(B1, 0, 1); PG8_SCHED; PG8_LDA(At, 0, 0); PG8_STAGE(PG8_SA(1, 1), a1 + hstep, voffA);
            PG8_WAIT_V(8); PG8_WAIT_L(0); PG8_BAR; PG8_MMA(0, 0, At, B0); PG8_MMA(0, 1, At, B1); PG8_BAR; PG8_SCHED;
            PG8_LDA(At, 0, 1); PG8_STAGE(PG8_SB(0, 0), b2, voffB); PG8_STAGE(PG8_SB(0, 1), b2 + hstep, voffB); PG8_STAGE(PG8_SA(0, 0), a2, voffA);
            PG8_WAIT_V(8); PG8_WAIT_L(0); PG8_BAR; PG8_MMA(1, 0, At, B0); PG8_MMA(1, 1, At, B1); PG8_BAR; PG8_SCHED;
            PG8_LDB(B0, 1, 0); PG8_LDB(B1, 1, 1); PG8_SCHED; PG8_LDA(At, 1, 0); PG8_STAGE(PG8_SA(0, 1), a2 + hstep, voffA);
            PG8_WAIT_V(8); PG8_WAIT_L(0); PG8_BAR; PG8_MMA(0, 0, At, B0); PG8_MMA(0, 1, At, B1); PG8_BAR; PG8_SCHED;
            PG8_LDA(At, 1, 1); PG8_STAGE(PG8_SB(1, 0), b3, voffB); PG8_STAGE(PG8_SB(1, 1), b3 + hstep, voffB); PG8_STAGE(PG8_SA(1, 0), a3, voffA);
            PG8_WAIT_V(8); PG8_WAIT_L(0); PG8_BAR; PG8_MMA(1, 0, At, B0); PG8_MMA(1, 1, At, B1); PG8_BAR; PG8_SCHED;
            } else {
            PG8_LDB(B0, 0, 0); PG8_SCHED; PG8_LDA(At, 0, 0); PG8_STAGE(PG8_SA(1, 1), a1 + hstep, voffA);
            PG8_WAIT_L(8); PG8_BAR; PG8_WAIT_L(0); PG8_MMA(0, 0, At, B0); PG8_BAR; PG8_SCHED;
            PG8_LDB(B1, 0, 1); PG8_STAGE(PG8_SB(0, 0), b2, voffB);
            PG8_BAR; PG8_WAIT_L(0); PG8_MMA(0, 1, At, B1); PG8_BAR;
            PG8_LDA(At, 0, 1); PG8_STAGE(PG8_SA(0, 0), a2, voffA);
            PG8_BAR; PG8_WAIT_L(0); PG8_MMA(1, 0, At, B0); PG8_BAR; PG8_SCHED;
            PG8_STAGE(PG8_SB(0, 1), b2 + hstep, voffB);
            PG8_WAIT_V(6); PG8_BAR; PG8_MMA(1, 1, At, B1); PG8_BAR;
            PG8_LDB(B0, 1, 0); PG8_SCHED; PG8_LDA(At, 1, 0); PG8_STAGE(PG8_SA(0, 1), a2 + hstep, voffA);
            PG8_WAIT_L(8); PG8_BAR; PG8_WAIT_L(0); PG8_MMA(0, 0, At, B0); PG8_BAR; PG8_SCHED;
            PG8_LDB(B1, 1, 1); PG8_STAGE(PG8_SB(1, 0), b3, voffB);
            PG8_BAR; PG8_WAIT_L(0); PG8_MMA(0, 1, At, B1); PG8_BAR;
            PG8_LDA(At, 1, 1); PG8_STAGE(PG8_SA(1, 0), a3, voffA);
            PG8_BAR; PG8_WAIT_L(0); PG8_MMA(1, 0, At, B0); PG8_BAR; PG8_SCHED;
            PG8_STAGE(PG8_SB(1, 1), b3 + hstep, voffB);
            PG8_WAIT_V(6); PG8_BAR; PG8_MMA(1, 1, At, B1); PG8_BAR;
            }
        }
        if constexpr (ALIGN_EPI) { if (wr == 0) PG8_BAR; }
        if constexpr (!Epi::AFTER_DRAIN) { E(acc, cur, wr, wc, fr, fq); S.done(cur); }
        if (!has_next) break;
#pragma unroll
        for (int a = 0; a < 2; ++a)
#pragma unroll
            for (int b = 0; b < 2; ++b)
#pragma unroll
                for (int m = 0; m < 4; ++m)
#pragma unroll
                    for (int n = 0; n < 2; ++n) acc[a][b][m][n] = (f32x4){0.f, 0.f, 0.f, 0.f};
        cur = nxt; cA = nA; cB = nB; ++ui;
        if constexpr (ALIGN_EPI) { if (wr == 1) PG8_BAR; }
    }
    PG8_WAIT_V(0);
    if constexpr (!ALIGN_EPI) { if (wr == 0) PG8_BAR; }
    PG8_BAR;
    if constexpr (Epi::AFTER_DRAIN) { E.fused(acc, cur, wr, wc, fr, fq, lds, wid, lane); S.done(cur); }
#undef PG8_SA
#undef PG8_SB
#undef PG8_STAGE
#undef PG8_LDA
#undef PG8_LDB
#undef PG8_MMA
#undef PG8_WAIT_V
#undef PG8_WAIT_L
#undef PG8_BAR
#undef PG8_SCHED
}
}


#define GAS __attribute__((address_space(1)))
#define LAS __attribute__((address_space(3)))
typedef unsigned short bf16;
typedef unsigned v4u __attribute__((ext_vector_type(4)));
typedef unsigned v2u __attribute__((ext_vector_type(2)));
typedef float f32x4 __attribute__((ext_vector_type(4)));
typedef float f32x16 __attribute__((ext_vector_type(16)));
typedef short bf16x8 __attribute__((ext_vector_type(8)));
typedef short s16x4 __attribute__((ext_vector_type(4)));
typedef GAS unsigned gu32;
#define RLX_AGENT __ATOMIC_RELAXED, __HIP_MEMORY_SCOPE_AGENT
#define LDS_WAIT() asm volatile("s_waitcnt lgkmcnt(0)" ::: "memory")
__device__ __forceinline__ unsigned f2bf(float f) { unsigned u = __builtin_bit_cast(unsigned, f); return (u + 0x7fffu + ((u >> 16) & 1u)) >> 16; }
__device__ __forceinline__ unsigned pk2(float lo, float hi) { return f2bf(lo) | (f2bf(hi) << 16); }
__device__ __forceinline__ float bflo(unsigned w) { return __uint_as_float(w << 16); }
__device__ __forceinline__ float bfhi(unsigned w) { return __uint_as_float(w & 0xffff0000u); }

constexpr size_t MiB = 1u << 20;
constexpr size_t WS_CTL = 0, CTL_ZERO_BYTES = 1 * MiB;
constexpr size_t WS_WIN = 1 * MiB;
constexpr size_t WS_WOAB = 12 * MiB;
constexpr size_t WS_WOUT = 14 * MiB;
constexpr size_t WS_KPART = 16 * MiB;
constexpr size_t WS_SEL = 17 * MiB;
constexpr size_t WS_XB = 20 * MiB;
constexpr size_t WS_YA = 20 * MiB, WS_YB = 52 * MiB;
constexpr size_t WS_QKZ = 84 * MiB;
constexpr size_t WS_T = 84 * MiB;
constexpr size_t WS_G = 252 * MiB;
constexpr size_t WS_VT = 380 * MiB;
constexpr size_t WS_MRG = 420 * MiB;
constexpr size_t WS_PML = 484 * MiB;
constexpr size_t WS_END = 490 * MiB;
constexpr int CW_Q3 = 64;
constexpr int CW_BAR = 4096;

#define XB_TMO      128
#define XB_XCNT(j)  (256  + 64 * (j))
#define XB_XSUB(j)  (1280 + 64 * (j))
#define XB_XGEN(j)  (2304 + 64 * (j))
#define XB_TOP      3328
#define XB_TOPGEN   3392
#define XCD_BAR_WORDS 3456
#define XB_SPIN_CAP (1u << 18)

__device__ __forceinline__ unsigned xb_ld(unsigned* p)              { return __hip_atomic_load(p, __ATOMIC_RELAXED, __HIP_MEMORY_SCOPE_AGENT); }
__device__ __forceinline__ unsigned xb_add(unsigned* p, unsigned v) { return __hip_atomic_fetch_add(p, v, __ATOMIC_RELAXED, __HIP_MEMORY_SCOPE_AGENT); }
__device__ __forceinline__ unsigned xb_xcc_id() { return (unsigned)__builtin_amdgcn_s_getreg((3 << 11) | 20) & 0xFu; }
#define XB_SPIN(cond, bar) do { unsigned _sp = 0; while (cond) { __builtin_amdgcn_s_sleep(1); \
    if ((++_sp & 255u) == 0u) { if (xb_ld(&(bar)[XB_TMO])) break; if (_sp > XB_SPIN_CAP) { atomicAdd(&(bar)[XB_TMO], 1u); break; } } } } while (0)

struct XcdBarrier {
    unsigned* bar; unsigned x;
    volatile LAS unsigned* st;
};

__device__ __forceinline__ XcdBarrier xcd_barrier_post(unsigned* bar, volatile LAS unsigned* st) {
    XcdBarrier b; b.bar = bar; b.x = xb_xcc_id(); b.st = st;
    if (threadIdx.x == 0) (void)xb_add(&bar[XB_XCNT(b.x)], 1u);
    return b;
}
__device__ __forceinline__ void xcd_barrier_complete(unsigned* bar, unsigned x, unsigned& nloc, unsigned& nx) {
    const unsigned G = gridDim.x * gridDim.y * gridDim.z;
    unsigned sum, cnt, mine, sp = 0u;
    for (;;) {
        sum = 0u; cnt = 0u; mine = 0u;
#pragma unroll
        for (unsigned j = 0; j < 16; ++j) { const unsigned c = xb_ld(&bar[XB_XCNT(j)]); sum += c; cnt += (c > 0u) ? 1u : 0u; mine = (j == x) ? c : mine; }
        if (sum == G) break;
        __builtin_amdgcn_s_sleep(1);
        if ((++sp & 255u) == 0u) { if (xb_ld(&bar[XB_TMO])) break; if (sp > XB_SPIN_CAP) { atomicAdd(&bar[XB_TMO], 1u); break; } }
    }
    nloc = mine > 0u ? mine : 1u; nx = cnt > 0u ? cnt : 1u;
}

__device__ __forceinline__ void xcd_barrier(const XcdBarrier& b) {
    asm volatile("s_waitcnt vmcnt(0)" ::: "memory");
    __syncthreads();
    if (threadIdx.x == 0) {
        unsigned* bar = b.bar;
        __builtin_amdgcn_s_waitcnt(0);
        unsigned nloc = b.st[0], nx = b.st[1];
        if (nloc == 0u) { xcd_barrier_complete(bar, b.x, nloc, nx); b.st[0] = nloc; b.st[1] = nx; }
        const unsigned old = xb_add(&bar[XB_XSUB(b.x)], 1u);
        const unsigned gen = old / nloc;
        if (old + 1u == (gen + 1u) * nloc) {
            __builtin_amdgcn_fence(__ATOMIC_RELEASE, "agent");
            asm volatile("s_waitcnt vmcnt(0)" ::: "memory");
            const unsigned og = xb_add(&bar[XB_TOP], 1u);
            const unsigned tg = og / nx;
            if (og + 1u == (tg + 1u) * nx) xb_add(&bar[XB_TOPGEN], 1u);
            else XB_SPIN(xb_ld(&bar[XB_TOPGEN]) == tg, bar);
            __builtin_amdgcn_fence(__ATOMIC_ACQUIRE, "agent");
            xb_add(&bar[XB_XGEN(b.x)], 1u);
            asm volatile("s_waitcnt vmcnt(0)" ::: "memory");
        } else {
            XB_SPIN(xb_ld(&bar[XB_XGEN(b.x)]) == gen, bar);
            __builtin_amdgcn_fence(__ATOMIC_ACQUIRE, "agent");
            asm volatile("s_waitcnt vmcnt(0)" ::: "memory");
        }
    }
    __syncthreads();
}

constexpr int RING_BYTES = 131072;
constexpr int LDSCTL_OFF = RING_BYTES, MISC_OFF = LDSCTL_OFF + 320;
constexpr int LDS_BYTES = 147456;
constexpr int NWAVES = 8;

struct Frame {
    LAS unsigned char* lds;
    volatile LAS unsigned* MISC;
    gu32* ctl;
    int tid, lane, wave, vcu, G;
    const float *x, *w_in, *b_gate, *sinks, *rel, *w_oa, *w_ob, *w_out, *gamma, *beta;
    float* out;
    bf16 *WinT, *WoabT, *WoutT, *XB, *YA, *YB, *QKZ, *GB, *VT, *MRG, *PO;
    float *kpart, *T, *PML; unsigned* SEL;
};

__device__ __forceinline__ void p0_transpose_item(const float* W, int K, int N, bf16* WT, int row_off, LAS float* scr, int item, int lane) {
    const int nblk = N / 32, kb = item / nblk, nb = item % nblk, k0 = 64 * kb, n0 = 32 * nb;
#pragma unroll 8
    for (int i = 0; i < 32; ++i) { const int kk = 2 * i + (lane >> 5); scr[kk * 33 + (lane & 31)] = W[(size_t)(k0 + kk) * N + n0 + (lane & 31)]; }
    LDS_WAIT(); asm volatile("" ::: "memory");
    const int c = lane & 7;
#pragma unroll
    for (int j = 0; j < 4; ++j) { const int n = (lane >> 3) + 8 * j; const LAS float* s = scr + (8 * c) * 33 + n;
        v4u o; o.x = pk2(s[0 * 33], s[1 * 33]); o.y = pk2(s[2 * 33], s[3 * 33]); o.z = pk2(s[4 * 33], s[5 * 33]); o.w = pk2(s[6 * 33], s[7 * 33]);
        *(GAS v4u*)(WT + (size_t)(row_off + n0 + n) * K + k0 + 8 * c) = o; }
    LDS_WAIT(); asm volatile("" ::: "memory");
}
__device__ __forceinline__ void p0_prologue(Frame& F) {
    LAS float* scr = (LAS float*)(F.lds + F.wave * 16384);
    const int gw = F.vcu * NWAVES + F.wave, NGW = F.G * NWAVES;
    constexpr int I_IN = (1024 / 64) * (NIN / 32), I_OA = (512 / 64) * (1024 / 32), I_OUT = (1024 / 64) * (1024 / 32);
    constexpr int NITEMS = I_IN + 2 * I_OA + I_OUT;
    for (int it = gw; it < NITEMS; it += NGW) {
        int r = it;
        if (r < I_IN) { p0_transpose_item(F.w_in, 1024, NIN, F.WinT, 0, scr, r, F.lane); continue; } r -= I_IN;
        if (r < I_OA) { p0_transpose_item(F.w_oa, 512, 1024, F.WoabT, 0, scr, r, F.lane); continue; } r -= I_OA;
        if (r < I_OA) { p0_transpose_item(F.w_ob, 512, 1024, F.WoabT, 1024, scr, r, F.lane); continue; } r -= I_OA;
        p0_transpose_item(F.w_out, 1024, 1024, F.WoutT, 0, scr, r, F.lane);
    }
    const size_t nchunk = (size_t)MTOK * DM / 8;
    for (size_t c = (size_t)blockIdx.x * 512 + F.tid; c < nchunk; c += (size_t)F.G * 512) {
        const f32x4 a = *(const GAS f32x4*)(F.x + c * 8), b = *(const GAS f32x4*)(F.x + c * 8 + 4);
        v4u o; o.x = pk2(a.x, a.y); o.y = pk2(a.z, a.w); o.z = pk2(b.x, b.y); o.w = pk2(b.z, b.w);
        *(GAS v4u*)(F.XB + c * 8) = o;
    }
}

__device__ __forceinline__ unsigned cvtpk(float lo, float hi) { typedef float f2 __attribute__((ext_vector_type(2))); typedef __bf16 b2 __attribute__((ext_vector_type(2))); f2 v = {lo, hi}; b2 b = __builtin_convertvector(v, b2); return __builtin_bit_cast(unsigned, b); }
__device__ __forceinline__ float ex2(float v) { return __builtin_amdgcn_exp2f(v); }
__device__ __forceinline__ float xhalf_max(float m) { auto rr = __builtin_amdgcn_permlane32_swap(__float_as_uint(m), __float_as_uint(m), false, false); return fmaxf(__uint_as_float(rr[0]), __uint_as_float(rr[1])); }
__device__ __forceinline__ float xhalf_sum(float m) { auto rr = __builtin_amdgcn_permlane32_swap(__float_as_uint(m), __float_as_uint(m), false, false); return __uint_as_float(rr[0]) + __uint_as_float(rr[1]); }
struct AttSt { f32x16 o0, o1; float m, l; };
__device__ __forceinline__ void att_init(AttSt& st) { st.o0 = f32x16{}; st.o1 = f32x16{}; st.m = -1e30f; st.l = 0.f; }
template <int MASK> __device__ __forceinline__ void bias_mask(f32x16& s, const LAS float* tab, int dbase, float sub) {
#pragma unroll
    for (int r = 0; r < 16; ++r) { const int d = dbase - ((r & 3) + 8 * (r >> 2)); const int di = d < 0 ? 0 : (d > 127 ? 127 : d);
        float v = s[r] + (tab[di] - sub);
        if (MASK == 1) v = d < 0 ? -INFINITY : v;
        if (MASK == 2) v = (d < 0 || d >= 128) ? -INFINITY : v;
        s[r] = v; }
}
__device__ __forceinline__ void softmax_pv(AttSt& st, f32x16& s, const bf16x8 (&vf)[2][2]) {
    float mt = fmaxf(s[0], s[1]);
#pragma unroll
    for (int r = 2; r < 16; ++r) mt = fmaxf(mt, s[r]);
    mt = xhalf_max(mt);
    const float mn = fmaxf(st.m, mt), alpha = ex2(st.m - mn);
    float sum = 0.f;
#pragma unroll
    for (int r = 0; r < 16; ++r) { s[r] = ex2(s[r] - mn); sum += s[r]; }
    st.l = st.l * alpha + sum; st.m = mn;
    st.o0 = st.o0 * alpha; st.o1 = st.o1 * alpha;
    v4u pw0, pw1;
    pw0.x = cvtpk(s[0], s[1]); pw0.y = cvtpk(s[2], s[3]); pw0.z = cvtpk(s[4], s[5]); pw0.w = cvtpk(s[6], s[7]);
    pw1.x = cvtpk(s[8], s[9]); pw1.y = cvtpk(s[10], s[11]); pw1.z = cvtpk(s[12], s[13]); pw1.w = cvtpk(s[14], s[15]);
    const bf16x8 p0 = __builtin_bit_cast(bf16x8, pw0), p1 = __builtin_bit_cast(bf16x8, pw1);
    st.o0 = __builtin_amdgcn_mfma_f32_32x32x16_bf16(vf[0][0], p0, st.o0, 0, 0, 0);
    st.o0 = __builtin_amdgcn_mfma_f32_32x32x16_bf16(vf[0][1], p1, st.o0, 0, 0, 0);
    st.o1 = __builtin_amdgcn_mfma_f32_32x32x16_bf16(vf[1][0], p0, st.o1, 0, 0, 0);
    st.o1 = __builtin_amdgcn_mfma_f32_32x32x16_bf16(vf[1][1], p1, st.o1, 0, 0, 0);
}
template <int MASK> __device__ __forceinline__ void tile_global(AttSt& st, const bf16x8 (&qf)[4], const bf16* Kg, const bf16* VTg, const LAS float* tab, int dbase, int lane) {
    const int r32 = lane & 31, hh = lane >> 5;
    bf16x8 kf[4], vf[2][2];
#pragma unroll
    for (int d0 = 0; d0 < 4; ++d0) kf[d0] = *(const GAS bf16x8*)(Kg + (size_t)r32 * QKZ_LD + 16 * d0 + 8 * hh);
#pragma unroll
    for (int dt = 0; dt < 2; ++dt)
#pragma unroll
        for (int s2 = 0; s2 < 2; ++s2) { const bf16* p = VTg + (size_t)(32 * dt + r32) * SEQ + 16 * s2 + 4 * hh;
            const s16x4 lo = *(const GAS s16x4*)p, hi = *(const GAS s16x4*)(p + 8);
            vf[dt][s2] = (bf16x8){lo[0], lo[1], lo[2], lo[3], hi[0], hi[1], hi[2], hi[3]}; }
    f32x16 s = f32x16{};
#pragma unroll
    for (int d0 = 0; d0 < 4; ++d0) s = __builtin_amdgcn_mfma_f32_32x32x16_bf16(kf[d0], qf[d0], s, 0, 0, 0);
    bias_mask<MASK>(s, tab, dbase, 0.f);
    softmax_pv(st, s, vf);
}
__device__ __forceinline__ int t5_bucket(int n) {
    if (n < 16) return n;
    const int large = 16 + (int)(logf((float)n / 16.0f) / 2.0794415416798357f * 16.0f);
    return large < 31 ? large : 31;
}
__device__ __forceinline__ void fill_tab(LAS float* tab, const float* rel, int col, int tid) {
    if (tid < 128) tab[tid] = rel[t5_bucket(tid) * 16 + col] * LOG2E;
}

__device__ __forceinline__ void gate_unit(Frame& F, int b, int h, int u) {
    LAS float* km = (LAS float*)F.lds;
    const int nk = 2 * u + 1;
    __syncthreads();
    for (int idx = F.tid; idx < nk * 64; idx += 512) { const int n = idx >> 6, d = idx & 63; const size_t pm = (size_t)(b * 32 + n);
        km[idx] = (F.kpart[(pm * 2) * 512 + h * 64 + d] + F.kpart[(pm * 2 + 1) * 512 + h * 64 + d]) * (1.0f / 256.0f); }
    __syncthreads();
    const int t = 512 * u + F.tid, j = t >> 8;
    const bf16* qp = F.QKZ + (size_t)(b * SEQ + t) * QKZ_LD + QB_OFF + h * 64;
    float q[64];
#pragma unroll
    for (int c = 0; c < 8; ++c) { const v4u w = *(const GAS v4u*)(qp + 8 * c);
        q[8 * c + 0] = bflo(w.x); q[8 * c + 1] = bfhi(w.x); q[8 * c + 2] = bflo(w.y); q[8 * c + 3] = bfhi(w.y);
        q[8 * c + 4] = bflo(w.z); q[8 * c + 5] = bfhi(w.z); q[8 * c + 6] = bflo(w.w); q[8 * c + 7] = bfhi(w.w); }
    float v0 = -INFINITY, v1 = -INFINITY, v2 = -INFINITY; unsigned i0 = 0xffu, i1 = 0xffu, i2 = 0xffu;
    for (int n = 0; n < j; ++n) {
        const LAS f32x4* kp = (const LAS f32x4*)(km + n * 64);
        float g0 = 0.f, g1 = 0.f;
#pragma unroll
        for (int c = 0; c < 16; c += 2) { const f32x4 a = kp[c], bb = kp[c + 1];
            g0 += q[4 * c] * a.x + q[4 * c + 1] * a.y + q[4 * c + 2] * a.z + q[4 * c + 3] * a.w;
            g1 += q[4 * c + 4] * bb.x + q[4 * c + 5] * bb.y + q[4 * c + 6] * bb.z + q[4 * c + 7] * bb.w; }
        const float g = g0 + g1;
        if (g > v0) { v2 = v1; i2 = i1; v1 = v0; i1 = i0; v0 = g; i0 = (unsigned)n; }
        else if (g > v1) { v2 = v1; i2 = i1; v1 = g; i1 = (unsigned)n; }
        else if (g > v2) { v2 = g; i2 = (unsigned)n; }
    }
    F.SEL[(size_t)(b * 8 + h) * SEQ + t] = i0 | (i1 << 8) | (i2 << 16);
}

constexpr int SEL_K_OFF = 0, SEL_KP = 144;
constexpr int SEL_V_OFF = 36864, SEL_VP = 520;
constexpr int SEL_TAB_OFF = 70144, SEL_Q_OFF = 70656;
__device__ __forceinline__ void sel_tile(Frame& F, int b, int h, int n, LAS unsigned* queue, unsigned head, int nvalid) {
    const int lane = F.lane, r32 = lane & 31, hh = lane >> 5;
    const unsigned e = queue[(head + (unsigned)(r32 < nvalid ? r32 : nvalid - 1)) & 127u];
    const int t = (int)(e & 0xffffu), slot = (int)(e >> 16);
    const size_t row = (size_t)(b * SEQ + t);
    const bf16* qp = F.QKZ + row * QKZ_LD + QB_OFF + h * 64 + 8 * hh;
    bf16x8 qf[4];
#pragma unroll
    for (int d0 = 0; d0 < 4; ++d0) qf[d0] = *(const GAS bf16x8*)(qp + 16 * d0);
    const LAS float* tab = (const LAS float*)(F.lds + SEL_TAB_OFF);
    const float t127 = tab[127];
    AttSt st; att_init(st);
    const LAS unsigned char* kb = F.lds + SEL_K_OFF + r32 * SEL_KP + 16 * hh;
    const LAS unsigned char* vb = F.lds + SEL_V_OFF + r32 * SEL_VP + 8 * hh;
#pragma unroll 1
    for (int kt = 0; kt < 8; ++kt) {
        bf16x8 kf[4], vf[2][2];
#pragma unroll
        for (int d0 = 0; d0 < 4; ++d0) kf[d0] = *(const LAS bf16x8*)(kb + kt * 32 * SEL_KP + 32 * d0);
#pragma unroll
        for (int dt = 0; dt < 2; ++dt)
#pragma unroll
            for (int s2 = 0; s2 < 2; ++s2) { const LAS unsigned char* p = vb + dt * 32 * SEL_VP + (kt * 32 + 16 * s2) * 2;
                const s16x4 lo = *(const LAS s16x4*)p, hi = *(const LAS s16x4*)(p + 16);
                vf[dt][s2] = (bf16x8){lo[0], lo[1], lo[2], lo[3], hi[0], hi[1], hi[2], hi[3]}; }
        f32x16 s = f32x16{};
#pragma unroll
        for (int d0 = 0; d0 < 4; ++d0) s = __builtin_amdgcn_mfma_f32_32x32x16_bf16(kf[d0], qf[d0], s, 0, 0, 0);
        const int key0 = 256 * n + 32 * kt;
        if (__any((t - (key0 + 31)) < 113)) bias_mask<0>(s, tab, t - key0 - 4 * hh, t127);
        softmax_pv(st, s, vf);
    }
    const float l = xhalf_sum(st.l);
    if (r32 < nvalid) {
        const size_t pidx = (row * 8 + h) * 3 + slot;
        v4u w0, w1, w2, w3;
        w0.x = cvtpk(st.o0[0], st.o0[1]); w0.y = cvtpk(st.o0[2], st.o0[3]); w0.z = cvtpk(st.o0[4], st.o0[5]); w0.w = cvtpk(st.o0[6], st.o0[7]);
        w1.x = cvtpk(st.o0[8], st.o0[9]); w1.y = cvtpk(st.o0[10], st.o0[11]); w1.z = cvtpk(st.o0[12], st.o0[13]); w1.w = cvtpk(st.o0[14], st.o0[15]);
        w2.x = cvtpk(st.o1[0], st.o1[1]); w2.y = cvtpk(st.o1[2], st.o1[3]); w2.z = cvtpk(st.o1[4], st.o1[5]); w2.w = cvtpk(st.o1[6], st.o1[7]);
        w3.x = cvtpk(st.o1[8], st.o1[9]); w3.y = cvtpk(st.o1[10], st.o1[11]); w3.z = cvtpk(st.o1[12], st.o1[13]); w3.w = cvtpk(st.o1[14], st.o1[15]);
        GAS v4u* po = (GAS v4u*)(F.PO + pidx * 64 + hh * 32);
        po[0] = w0; po[1] = w1; po[2] = w2; po[3] = w3;
        if (hh == 0) { typedef float f2 __attribute__((ext_vector_type(2))); *(GAS f2*)(F.PML + pidx * 2) = (f2){st.m + t127, l}; }
    }
}
__device__ __forceinline__ void sel_unit(Frame& F, int b, int h, int n) {
    const int tid = F.tid, lane = F.lane, wid = F.wave;
    const bf16* Kg = F.QKZ + (size_t)(b * SEQ + 256 * n) * QKZ_LD + KB_OFF + h * 64;
    const bf16* Vg = F.VT + (size_t)(b * NVH + 2 + h) * 64 * SEQ + 256 * n;
#pragma unroll
    for (int i = 0; i < 4; ++i) { const int idx = tid + 512 * i, key = idx >> 3, ch = idx & 7;
        const v4u v = *(const GAS v4u*)(Kg + (size_t)key * QKZ_LD + ch * 8);
        *(LAS v4u*)(F.lds + SEL_K_OFF + key * SEL_KP + ch * 16) = v; }
#pragma unroll
    for (int i = 0; i < 4; ++i) { const int idx = tid + 512 * i, d = idx >> 5, ch = idx & 31;
        const v4u v = *(const GAS v4u*)(Vg + (size_t)d * SEQ + ch * 8);
        LAS v2u* p = (LAS v2u*)(F.lds + SEL_V_OFF + d * SEL_VP + ch * 16); p[0] = (v2u){v.x, v.y}; p[1] = (v2u){v.z, v.w}; }
    fill_tab((LAS float*)(F.lds + SEL_TAB_OFF), F.rel, 8 + h, tid);
    __syncthreads();
    LAS unsigned* queue = (LAS unsigned*)(F.lds + SEL_Q_OFF) + wid * 128;
    const unsigned* selp = F.SEL + (size_t)(b * 8 + h) * SEQ;
    const int nchunks = 4 * (31 - n);
    unsigned head = 0; int cnt = 0;
    for (int c = wid;; c += NWAVES) {
        const bool more = c < nchunks;
        if (more) {
            const int t = 256 * (n + 1) + 64 * c + lane;
            const unsigned sel = selp[t];
            const int slot = ((sel & 0xffu) == (unsigned)n) ? 0 : (((sel >> 8) & 0xffu) == (unsigned)n) ? 1 : (((sel >> 16) & 0xffu) == (unsigned)n) ? 2 : -1;
            const unsigned long long mask = __ballot(slot >= 0);
            if (slot >= 0) { const int pos = __builtin_amdgcn_mbcnt_hi((unsigned)(mask >> 32), __builtin_amdgcn_mbcnt_lo((unsigned)mask, 0u));
                queue[(head + (unsigned)(cnt + pos)) & 127u] = (unsigned)t | ((unsigned)slot << 16); }
            cnt += __builtin_popcountll(mask);
            LDS_WAIT(); asm volatile("" ::: "memory");
        }
#pragma unroll 1
        while (cnt >= 32 || (!more && cnt > 0)) { const int nv = cnt < 32 ? cnt : 32; sel_tile(F, b, h, n, queue, head, nv); head = (head + (unsigned)nv) & 127u; cnt -= nv; }
        if (!more) break;
    }
}

__device__ __forceinline__ void swa_unit(Frame& F, int b, int a, int blk) {
    LAS float* tab = (LAS float*)(F.lds + SEL_TAB_OFF);
    fill_tab(tab, F.rel, a, F.tid);
    __syncthreads();
    const int lane = F.lane, r32 = lane & 31, hh = lane >> 5, kvh = a >> 2;
    const int t0 = 256 * blk + 32 * F.wave, t = t0 + r32;
    const size_t row = (size_t)(b * SEQ + t);
    const bf16* qp = F.QKZ + row * QKZ_LD + QA_OFF + a * 64 + 8 * hh;
    bf16x8 qf[4];
#pragma unroll
    for (int d0 = 0; d0 < 4; ++d0) qf[d0] = *(const GAS bf16x8*)(qp + 16 * d0);
    const bf16* Kb = F.QKZ + (size_t)b * SEQ * QKZ_LD + KA_OFF + kvh * 64;
    const bf16* Vb = F.VT + (size_t)(b * NVH + kvh) * 64 * SEQ;
    AttSt st; att_init(st);
#pragma unroll 1
    for (int i = 0; i < 5; ++i) { const int key0 = t0 - 128 + 32 * i; if (key0 < 0) continue;
        const int dbase = t - key0 - 4 * hh;
        if (i == 0 || i == 4) tile_global<2>(st, qf, Kb + (size_t)key0 * QKZ_LD, Vb + key0, tab, dbase, lane);
        else tile_global<0>(st, qf, Kb + (size_t)key0 * QKZ_LD, Vb + key0, tab, dbase, lane); }
    float l = xhalf_sum(st.l);
    l += ex2(F.sinks[a] * LOG2E - st.m);
    const float inv = 1.0f / l;
    const bf16* zp = F.QKZ + row * QKZ_LD + ZA_OFF + a * 64;
    bf16* yp = F.YA + row * 512 + a * 64;
#pragma unroll
    for (int dt = 0; dt < 2; ++dt)
#pragma unroll
        for (int g = 0; g < 4; ++g) { const int d = 32 * dt + 8 * g + 4 * hh;
            const v2u z = *(const GAS v2u*)(zp + d);
            const f32x16& o = dt ? st.o1 : st.o0;
            v2u y; y.x = cvtpk(o[4 * g] * inv * bflo(z.x), o[4 * g + 1] * inv * bfhi(z.x)); y.y = cvtpk(o[4 * g + 2] * inv * bflo(z.y), o[4 * g + 3] * inv * bfhi(z.y));
            *(GAS v2u*)(yp + d) = y; }
}

__device__ __forceinline__ void own_sub(Frame& F, int b, int h, int j, int w) {
    const LAS float* tab = (const LAS float*)(F.lds + SEL_TAB_OFF);
    const int lane = F.lane, r32 = lane & 31, hh = lane >> 5;
    const int t0 = 256 * j + 32 * w, t = t0 + r32;
    const size_t row = (size_t)(b * SEQ + t);
    const bf16* qp = F.QKZ + row * QKZ_LD + QB_OFF + h * 64 + 8 * hh;
    bf16x8 qf[4];
#pragma unroll
    for (int d0 = 0; d0 < 4; ++d0) qf[d0] = *(const GAS bf16x8*)(qp + 16 * d0);
    const bf16* Kb = F.QKZ + (size_t)b * SEQ * QKZ_LD + KB_OFF + h * 64;
    const bf16* Vb = F.VT + (size_t)(b * NVH + 2 + h) * 64 * SEQ;
    AttSt st; att_init(st);
#pragma unroll 1
    for (int kt = 0; kt <= w; ++kt) { const int key0 = 256 * j + 32 * kt; const int dbase = t - key0 - 4 * hh;
        if (kt == w) tile_global<1>(st, qf, Kb + (size_t)key0 * QKZ_LD, Vb + key0, tab, dbase, lane);
        else tile_global<0>(st, qf, Kb + (size_t)key0 * QKZ_LD, Vb + key0, tab, dbase, lane); }
    const float l0 = xhalf_sum(st.l);
    const int nsel = j < 3 ? j : 3;
    float ms[3], ls[3]; float M = st.m;
#pragma unroll
    for (int s = 0; s < 3; ++s) { ms[s] = -1e30f; ls[s] = 0.f;
        if (s < nsel) { typedef float f2 __attribute__((ext_vector_type(2))); const f2 ml = *(const GAS f2*)(F.PML + ((row * 8 + h) * 3 + s) * 2); ms[s] = ml.x; ls[s] = ml.y; M = fmaxf(M, ml.x); } }
    const float w0 = ex2(st.m - M);
    float L = w0 * l0; f32x16 o0 = st.o0 * w0, o1 = st.o1 * w0;
#pragma unroll
    for (int s = 0; s < 3; ++s) if (s < nsel) { const float ws = ex2(ms[s] - M); L += ws * ls[s];
        const GAS v4u* po = (const GAS v4u*)(F.PO + ((row * 8 + h) * 3 + s) * 64 + hh * 32);
        const v4u a0 = po[0], a1 = po[1], a2 = po[2], a3 = po[3];
        o0[0] += ws * bflo(a0.x); o0[1] += ws * bfhi(a0.x); o0[2] += ws * bflo(a0.y); o0[3] += ws * bfhi(a0.y); o0[4] += ws * bflo(a0.z); o0[5] += ws * bfhi(a0.z); o0[6] += ws * bflo(a0.w); o0[7] += ws * bfhi(a0.w);
        o0[8] += ws * bflo(a1.x); o0[9] += ws * bfhi(a1.x); o0[10] += ws * bflo(a1.y); o0[11] += ws * bfhi(a1.y); o0[12] += ws * bflo(a1.z); o0[13] += ws * bfhi(a1.z); o0[14] += ws * bflo(a1.w); o0[15] += ws * bfhi(a1.w);
        o1[0] += ws * bflo(a2.x); o1[1] += ws * bfhi(a2.x); o1[2] += ws * bflo(a2.y); o1[3] += ws * bfhi(a2.y); o1[4] += ws * bflo(a2.z); o1[5] += ws * bfhi(a2.z); o1[6] += ws * bflo(a2.w); o1[7] += ws * bfhi(a2.w);
        o1[8] += ws * bflo(a3.x); o1[9] += ws * bfhi(a3.x); o1[10] += ws * bflo(a3.y); o1[11] += ws * bfhi(a3.y); o1[12] += ws * bflo(a3.z); o1[13] += ws * bfhi(a3.z); o1[14] += ws * bflo(a3.w); o1[15] += ws * bfhi(a3.w); }
    const float inv = 1.0f / L;
    const bf16* zp = F.QKZ + row * QKZ_LD + ZB_OFF + h * 64;
    bf16* yp = F.YB + row * 512 + h * 64;
#pragma unroll
    for (int dt = 0; dt < 2; ++dt)
#pragma unroll
        for (int g = 0; g < 4; ++g) { const int d = 32 * dt + 8 * g + 4 * hh;
            const v2u z = *(const GAS v2u*)(zp + d);
            const f32x16& o = dt ? o1 : o0;
            v2u y; y.x = cvtpk(o[4 * g] * inv * bflo(z.x), o[4 * g + 1] * inv * bfhi(z.x)); y.y = cvtpk(o[4 * g + 2] * inv * bflo(z.y), o[4 * g + 3] * inv * bfhi(z.y));
            *(GAS v2u*)(yp + d) = y; }
}

__device__ __forceinline__ float wave_sum(float v) {
#pragma unroll
    for (int o = 1; o < 64; o <<= 1) v += __shfl_xor(v, o);
    return v;
}
__device__ __forceinline__ void ln_rows(Frame& F) {
    const int gw = F.vcu * NWAVES + F.wave, NGW = F.G * NWAVES;
    f32x4 gm[4], bt[4];
#pragma unroll
    for (int jj = 0; jj < 4; ++jj) { gm[jj] = *((const GAS f32x4*)F.gamma + F.lane + 64 * jj); bt[jj] = *((const GAS f32x4*)F.beta + F.lane + 64 * jj); }
    for (int m = gw; m < MTOK; m += NGW) {
        GAS f32x4* xr = (GAS f32x4*)(F.out + (size_t)m * DM) + F.lane;
        f32x4 v[4]; float s = 0.f;
#pragma unroll
        for (int jj = 0; jj < 4; ++jj) { v[jj] = xr[64 * jj]; s += (v[jj].x + v[jj].y) + (v[jj].z + v[jj].w); }
        const float mean = wave_sum(s) * (1.f / DM); float s2 = 0.f;
#pragma unroll
        for (int jj = 0; jj < 4; ++jj) { v[jj] = v[jj] - mean; s2 += (v[jj].x * v[jj].x + v[jj].y * v[jj].y) + (v[jj].z * v[jj].z + v[jj].w * v[jj].w); }
        const float rstd = 1.f / sqrtf(wave_sum(s2) * (1.f / DM) + LN_EPS);
#pragma unroll
        for (int jj = 0; jj < 4; ++jj) { f32x4 o = v[jj] * rstd * gm[jj] + bt[jj];
#if defined(DIAG) && (DIAG & 4)
            o.x = __uint_as_float(f2bf(o.x) << 16); o.y = __uint_as_float(f2bf(o.y) << 16); o.z = __uint_as_float(f2bf(o.z) << 16); o.w = __uint_as_float(f2bf(o.w) << 16);
#endif
            xr[64 * jj] = o; }
    }
}

struct Args { const float* in[10]; float* out; unsigned char* ws; int ph_lo, ph_hi; };
constexpr int NPHASE = 8;
__global__ void __launch_bounds__(NWAVES * 64, 2) fwd(Args args) {
    extern __shared__ __attribute__((aligned(16))) unsigned char lds[];
    Frame F;
    F.lds = (LAS unsigned char*)lds;
    F.MISC = (volatile LAS unsigned*)(F.lds + MISC_OFF);
    F.tid = threadIdx.x; F.lane = F.tid & 63; F.wave = __builtin_amdgcn_readfirstlane(F.tid >> 6);
    F.G = gridDim.x; { const int bx = blockIdx.x; F.vcu = (F.G % 8 == 0) ? (bx % 8) * (F.G / 8) + bx / 8 : bx; }
    unsigned char* ws = args.ws;
    F.ctl = (gu32*)(ws + WS_CTL);
    F.x = args.in[0]; F.w_in = args.in[1]; F.b_gate = args.in[2]; F.sinks = args.in[3]; F.rel = args.in[4];
    F.w_oa = args.in[5]; F.w_ob = args.in[6]; F.w_out = args.in[7]; F.gamma = args.in[8]; F.beta = args.in[9]; F.out = args.out;
    F.WinT = (bf16*)(ws + WS_WIN); F.WoabT = (bf16*)(ws + WS_WOAB); F.WoutT = (bf16*)(ws + WS_WOUT);
    F.XB = (bf16*)(ws + WS_XB); F.YA = (bf16*)(ws + WS_YA); F.YB = (bf16*)(ws + WS_YB); F.QKZ = (bf16*)(ws + WS_QKZ);
    F.GB = (bf16*)(ws + WS_G); F.VT = (bf16*)(ws + WS_VT); F.MRG = (bf16*)(ws + WS_MRG); F.PO = (bf16*)args.out;
    F.kpart = (float*)(ws + WS_KPART); F.T = (float*)(ws + WS_T); F.PML = (float*)(ws + WS_PML); F.SEL = (unsigned*)(ws + WS_SEL);
    for (int u = F.tid; u < (LDS_BYTES - LDSCTL_OFF) / 4; u += NWAVES * 64) ((LAS unsigned*)(F.lds + LDSCTL_OFF))[u] = 0u;
    __syncthreads();
    const int lo = args.ph_lo, hi = args.ph_hi;
    XcdBarrier bar; bar.bar = (unsigned*)(F.ctl + CW_BAR); bar.x = 0; bar.st = nullptr;
    if (hi - lo > 1) bar = xcd_barrier_post((unsigned*)(F.ctl + CW_BAR), F.MISC + 8);
#ifndef PHASE_MASK
#define PHASE_MASK 0xff
#endif
#define IN(k) (((PHASE_MASK >> (k)) & 1) && lo <= (k) && (k) < hi)
#define SEAM(k) do { if (IN(k) && IN((k) + 1)) xcd_barrier(bar); } while (0)

    if (IN(0)) { p0_prologue(F); SEAM(0); }

    if (IN(1)) {
        pg8::Gemm g{F.XB, nullptr, F.WinT, MTOK, NIN, 1024}; pg8::StaticOrder S; S.init(MTOK, NIN, F.G, (int)blockIdx.x);
        pg8::Epi1 E{F.QKZ, F.GB, F.VT, F.kpart, F.b_gate};
        pg8::gemm_phase<pg8::Epi1, pg8::StaticOrder, true, true>(F.lds, g, S, E);
        SEAM(1);
    }

    if (IN(2)) {
        for (int u = F.vcu; u < 512; u += F.G) gate_unit(F, u >> 7, (u >> 4) & 7, 15 - (u & 15));
        SEAM(2);
    }

    if (IN(3)) {
        for (;;) {
            __syncthreads();
            if (F.tid == 0) F.MISC[0] = __hip_atomic_fetch_add(F.ctl + CW_Q3, 1u, RLX_AGENT);
            __syncthreads();
            const int id = (int)F.MISC[0];
            if (id >= 992 + 1024) break;
            if (id < 992) sel_unit(F, (id & 31) >> 3, id & 7, id >> 5);
            else { const int s = id - 992; swa_unit(F, s >> 8, (s >> 5) & 7, s & 31); }
        }
        SEAM(3);
    }

    if (IN(4)) {
        for (int u = F.vcu; u < 512; u += F.G) { const int b = u >> 7, h = (u >> 4) & 7, jp = u & 15;
            __syncthreads();
            fill_tab((LAS float*)(F.lds + SEL_TAB_OFF), F.rel, 8 + h, F.tid);
            __syncthreads();
            own_sub(F, b, h, 2 * jp, F.wave); own_sub(F, b, h, 2 * jp + 1, 7 - F.wave); }
        SEAM(4);
    }

    if (IN(5)) {
        __syncthreads();
        pg8::Gemm g{F.YA, F.YB, F.WoabT, MTOK, 2048, 512}; pg8::OrderOut S{F.vcu, F.G};
        pg8::EpiOut E{F.GB, F.T, F.MRG};
        pg8::gemm_phase<pg8::EpiOut, pg8::OrderOut, true, true>(F.lds, g, S, E);
        SEAM(5);
    }

    if (IN(6)) {
        pg8::Gemm g{F.MRG, nullptr, F.WoutT, MTOK, 1024, 1024}; pg8::OrderRes S{F.vcu, F.G};
        pg8::EpiRes E{F.x, F.out};
        pg8::gemm_phase<pg8::EpiRes, pg8::OrderRes, true, true>(F.lds, g, S, E);
        SEAM(6);
    }

    if (IN(7)) { ln_rows(F); }
#undef IN
#undef SEAM
}

#ifndef N_LAUNCHES
#define N_LAUNCHES 1
#endif
extern "C" void kernel_launch(void* const* d_in, const int* in_sizes, int n_in, void* d_out, int out_size, void* d_ws, size_t ws_size, hipStream_t stream) {
    static int grid = 0;
    if (grid == 0) {
        if (n_in != 10 || in_sizes[0] != MTOK * DM || out_size != MTOK * DM || ws_size < WS_END) {
            fprintf(stderr, "kernel_launch: unexpected shapes (n_in %d, in0 %d, out %d, ws %zu); nothing launched\n", n_in, n_in > 0 ? in_sizes[0] : -1, out_size, ws_size); grid = -1; return; }
        int dev = 0, cus = 0, per_cu = 0;
        if (hipGetDevice(&dev) != hipSuccess || hipDeviceGetAttribute(&cus, hipDeviceAttributeMultiprocessorCount, dev) != hipSuccess) { grid = -1; return; }
        if (hipFuncSetAttribute((const void*)fwd, hipFuncAttributeMaxDynamicSharedMemorySize, LDS_BYTES) != hipSuccess) { fprintf(stderr, "kernel_launch: hipFuncSetAttribute failed\n"); grid = -1; return; }
        if (hipOccupancyMaxActiveBlocksPerMultiprocessor(&per_cu, (const void*)fwd, NWAVES * 64, LDS_BYTES) != hipSuccess || per_cu < 1) { fprintf(stderr, "kernel_launch: occupancy query says %d blocks per CU\n", per_cu); per_cu = 1; }
        (void)hipGetLastError();
        grid = cus;
    }
    if (grid < 0) return;
    (void)hipMemsetAsync((char*)d_ws + WS_CTL, 0, CTL_ZERO_BYTES, stream);
    Args a{};
    for (int i = 0; i < 10; ++i) a.in[i] = (const float*)d_in[i];
    a.out = (float*)d_out; a.ws = (unsigned char*)d_ws;
    for (int li = 0; li < N_LAUNCHES; ++li) {
        a.ph_lo = li * NPHASE / N_LAUNCHES; a.ph_hi = (li + 1) * NPHASE / N_LAUNCHES;
        hipLaunchKernelGGL(fwd, dim3(grid), dim3(NWAVES * 64), LDS_BYTES, stream, a);
    }
}
```

```cpp
#include <hip/hip_runtime.h>
#include <cstdio>
#include <cstdint>

constexpr int BATCH = 4, SEQ = 8192, DM = 1024, MTOK = BATCH * SEQ, NIN = 5376;
constexpr int QKZ_LD = 2688, G_LD = 2048;
constexpr int QA_OFF = 0, KA_OFF = 512, ZA_OFF = 640, QB_OFF = 1152, KB_OFF = 1664, ZB_OFF = 2176;
constexpr int NVH = 10;
constexpr float LOG2E = 1.4426950408889634f;
constexpr float QS = 0.125f * LOG2E;
constexpr float DN_ALPHA = 1.189207115002721f;
constexpr float LN_EPS = 1e-5f;

namespace pg8 {
#define PG8_LAS __attribute__((address_space(3)))
typedef unsigned short bf16_t;
typedef short bf16x8 __attribute__((ext_vector_type(8)));
typedef float f32x4 __attribute__((ext_vector_type(4)));
typedef unsigned u32x4 __attribute__((ext_vector_type(4)));
constexpr int BM = 256, BK = 64, HALF = 128, HTB = HALF * BK * 2  , STAGE_BYTES = 8 * HTB, NXCD = 8, WGM = 8;

__host__ __device__ __forceinline__ int lds_byte(int r, int c) { const int st = (r >> 4) * 2 + (c >> 5), rr = r & 15, cc = c & 31, ob = rr * 64 + cc * 2; return st * 1024 + (ob ^ (((ob >> 9) & 1) << 5)); }
__host__ __device__ __forceinline__ void stage_rc(int b, int& R, int& C) { const int st = b / 1024, sb = b % 1024, swz = sb ^ (((sb >> 9) & 1) << 5); R = (st >> 1) * 16 + swz / 64; C = (st & 1) * 32 + (swz % 64) / 2; }
__host__ __device__ __forceinline__ int perm32(int rho) { const int n = rho >> 4, i = rho & 15; return 8 * (i >> 2) + 4 * n + (i & 3); }

struct Unit { int pm, pn; };
struct Gemm { const bf16_t* A; const bf16_t* A2; const bf16_t* Bt; int M, N, K; };

struct StaticOrder {
    int nM, nN, nwg, G, c;
    __host__ __device__ void init(int M, int N, int G_, int c_) { nM = M / BM; nN = N / BM; nwg = nM * nN; G = G_; c = c_; }
    __host__ __device__ bool next(int i, Unit& u) const {
        const long L = (long)i * G + c; if (L >= nwg) return false;
        int wgid = (int)L; { const int q = nwg / NXCD, r = nwg % NXCD, xcd = wgid % NXCD, off = wgid / NXCD; wgid = (xcd < r ? xcd * (q + 1) : r * (q + 1) + (xcd - r) * q) + off; }
        const int nig = WGM * nN, gid = wgid / nig, fm = gid * WGM, gsz = (nM - fm) < WGM ? (nM - fm) : WGM;
        u.pm = fm + ((wgid % nig) % gsz); u.pn = (wgid % nig) / gsz; return true;
    }
    __device__ __forceinline__ const char* aptr(const Gemm& g, const Unit& u, size_t tstep) const { return (const char*)g.A + (size_t)u.pm * tstep; }
    __device__ __forceinline__ const char* bptr(const Gemm& g, const Unit& u, size_t tstep) const { return (const char*)g.Bt + (size_t)u.pn * tstep; }
    __device__ __forceinline__ void a_ready(const Unit&) const {}
    __device__ __forceinline__ void done(const Unit&) const {}
};

__device__ __forceinline__ unsigned cvt_pk_bf16(float lo, float hi) { unsigned r; asm volatile("v_cvt_pk_bf16_f32 %0, %1, %2" : "=v"(r) : "v"(lo), "v"(hi)); return r; }
typedef float f32x2 __attribute__((ext_vector_type(2)));

__device__ __forceinline__ float bf_lo(unsigned w) { return __uint_as_float(w << 16); }
__device__ __forceinline__ float bf_hi(unsigned w) { return __uint_as_float(w & 0xffff0000u); }
__device__ __forceinline__ float sigmoidf_(float x) { return __builtin_amdgcn_rcpf(1.0f + __builtin_amdgcn_exp2f(-x * 1.4426950408889634f)); }

struct Epi1 {
    static constexpr bool PERM = true, AFTER_DRAIN = false;
    bf16_t* QKZ; bf16_t* G; bf16_t* VT; float* kpart; const float* bgate;
    __device__ __forceinline__ void operator()(const f32x4 (&acc)[2][2][4][2], const Unit& u, int wr, int wc, int fr, int fq) const {
        const int row0 = u.pm * 256 + wr * 64 + fr;
        const int cl = wc * 32 + 8 * fq;
#pragma unroll
        for (int bj = 0; bj < 2; ++bj) {
            const int cb = u.pn * 256 + bj * 128;
            int mode, dcol;
            if (cb < 512) { mode = 0; dcol = cb; }
            else if (cb < 640) { mode = 1; dcol = cb; }
            else if (cb < 768) { mode = 2; dcol = cb - 640; }
            else if (cb < 1280) { mode = 3; dcol = cb - 128; }
            else if (cb < 1792) { mode = 0; dcol = cb - 128; }
            else if (cb < 2304) { mode = 1; dcol = cb - 128; }
            else if (cb < 2816) { mode = 2; dcol = cb - 2304 + 128; }
            else if (cb < 3328) { mode = 3; dcol = cb - 640; }
            else { mode = 4; dcol = cb - 3328; }
            if (mode == 2) {
                const int b = u.pm >> 5, t0 = (u.pm & 31) * 256 + wr * 64 + fr, dc = dcol + cl, vh = dc >> 6, d0 = dc & 63;
                bf16_t* p = VT + ((size_t)(b * 10 + vh) * 64 + d0) * 8192 + t0;
#pragma unroll
                for (int ai = 0; ai < 2; ++ai)
#pragma unroll
                    for (int m = 0; m < 4; ++m)
#pragma unroll
                        for (int n = 0; n < 2; ++n) { const f32x4 v = acc[ai][bj][m][n]; const unsigned w0 = cvt_pk_bf16(v[0], v[1]), w1 = cvt_pk_bf16(v[2], v[3]);
                            bf16_t* q = p + (size_t)(4 * n) * 8192 + ai * 128 + m * 16;
                            q[0] = (bf16_t)(w0 & 0xffffu); q[8192] = (bf16_t)(w0 >> 16); q[2 * 8192] = (bf16_t)(w1 & 0xffffu); q[3 * 8192] = (bf16_t)(w1 >> 16); }
            } else if (mode == 4) {
                const f32x4 b0 = *(const f32x4*)(bgate + dcol + cl), b1 = *(const f32x4*)(bgate + dcol + cl + 4);
#pragma unroll
                for (int ai = 0; ai < 2; ++ai)
#pragma unroll
                    for (int m = 0; m < 4; ++m) { f32x4 v0 = acc[ai][bj][m][0] + b0, v1 = acc[ai][bj][m][1] + b1;
#pragma unroll
                        for (int i = 0; i < 4; ++i) { v0[i] = sigmoidf_(v0[i]); v1[i] = sigmoidf_(v1[i]); }
                        u32x4 w; w.x = cvt_pk_bf16(v0[0], v0[1]); w.y = cvt_pk_bf16(v0[2], v0[3]); w.z = cvt_pk_bf16(v1[0], v1[1]); w.w = cvt_pk_bf16(v1[2], v1[3]);
                        *(u32x4*)(G + (size_t)(row0 + ai * 128 + m * 16) * 2048 + dcol + cl) = w; }
            } else {
#pragma unroll
                for (int ai = 0; ai < 2; ++ai)
#pragma unroll
                    for (int m = 0; m < 4; ++m) { f32x4 v0 = acc[ai][bj][m][0], v1 = acc[ai][bj][m][1];
                        if (mode == 0) { v0 = v0 * (0.125f * 1.4426950408889634f); v1 = v1 * (0.125f * 1.4426950408889634f); }
                        else if (mode == 3) {
#pragma unroll
                            for (int i = 0; i < 4; ++i) { v0[i] = v0[i] * sigmoidf_(v0[i]); v1[i] = v1[i] * sigmoidf_(v1[i]); } }
                        u32x4 w; w.x = cvt_pk_bf16(v0[0], v0[1]); w.y = cvt_pk_bf16(v0[2], v0[3]); w.z = cvt_pk_bf16(v1[0], v1[1]); w.w = cvt_pk_bf16(v1[2], v1[3]);
                        *(u32x4*)(QKZ + (size_t)(row0 + ai * 128 + m * 16) * 2688 + dcol + cl) = w; }
                if (cb >= 1792 && cb < 2304) {
                    float s[8];
#pragma unroll
                    for (int n = 0; n < 2; ++n)
#pragma unroll
                        for (int i = 0; i < 4; ++i) { float t = 0.f;
#pragma unroll
                            for (int ai = 0; ai < 2; ++ai)
#pragma unroll
                                for (int m = 0; m < 4; ++m) t += acc[ai][bj][m][n][i];
                            t += __shfl_xor(t, 1); t += __shfl_xor(t, 2); t += __shfl_xor(t, 4); t += __shfl_xor(t, 8); s[4 * n + i] = t; }
                    if (fr == 0) { float* kp = kpart + (size_t)(u.pm * 2 + wr) * 512 + (cb - 1792) + cl;
                        *(f32x4*)kp = (f32x4){s[0], s[1], s[2], s[3]}; *(f32x4*)(kp + 4) = (f32x4){s[4], s[5], s[6], s[7]}; }
                }
            }
        }
    }
};

struct EpiOut {
    static constexpr bool PERM = true, AFTER_DRAIN = false;
    const bf16_t* G; bf16_t* T; bf16_t* MRG;
    __device__ __forceinline__ void operator()(const f32x4 (&acc)[2][2][4][2], const Unit& u, int wr, int wc, int fr, int fq) const {
        const int half = u.pn >> 2, pnc = u.pn & 3, row0 = u.pm * 256 + wr * 64 + fr;
#pragma unroll
        for (int bj = 0; bj < 2; ++bj) { const int c0 = pnc * 256 + bj * 128 + wc * 32 + 8 * fq;
#pragma unroll
            for (int ai = 0; ai < 2; ++ai)
#pragma unroll
                for (int m = 0; m < 4; ++m) { const size_t row = (size_t)(row0 + ai * 128 + m * 16);
                    const u32x4 gw = *(const u32x4*)(G + row * 2048 + half * 1024 + c0);
                    f32x4 v0 = acc[ai][bj][m][0] * (f32x4){bf_lo(gw.x), bf_hi(gw.x), bf_lo(gw.y), bf_hi(gw.y)};
                    f32x4 v1 = acc[ai][bj][m][1] * (f32x4){bf_lo(gw.z), bf_hi(gw.z), bf_lo(gw.w), bf_hi(gw.w)};
#if defined(DIAG) && (DIAG & 1)
                    if (half == 0) { v0 = v0 * 0.f; v1 = v1 * 0.f; }
#endif
#if defined(DIAG) && (DIAG & 2)
                    if (half == 1) { v0 = v0 * 0.f; v1 = v1 * 0.f; }
#endif
                    bf16_t* tp = T + row * 1024 + c0;
                    if (half == 0) { u32x4 w; w.x = cvt_pk_bf16(v0[0], v0[1]); w.y = cvt_pk_bf16(v0[2], v0[3]); w.z = cvt_pk_bf16(v1[0], v1[1]); w.w = cvt_pk_bf16(v1[2], v1[3]); *(u32x4*)tp = w; }
                    else { const u32x4 tw = *(const u32x4*)tp;
                        v0 += (f32x4){bf_lo(tw.x), bf_hi(tw.x), bf_lo(tw.y), bf_hi(tw.y)}; v1 += (f32x4){bf_lo(tw.z), bf_hi(tw.z), bf_lo(tw.w), bf_hi(tw.w)};
                        u32x4 w; w.x = cvt_pk_bf16(v0[0], v0[1]); w.y = cvt_pk_bf16(v0[2], v0[3]); w.z = cvt_pk_bf16(v1[0], v1[1]); w.w = cvt_pk_bf16(v1[2], v1[3]);
                        *(u32x4*)(MRG + row * 1024 + c0) = w; } } }
    }
};

struct EpiRes {
    static constexpr bool PERM = false, AFTER_DRAIN = false;
    const float* x; float* out;
    __device__ __forceinline__ void operator()(const f32x4 (&acc)[2][2][4][2], const Unit& u, int wr, int wc, int fr, int fq) const {
        const int row0 = u.pm * 256 + wr * 64 + fr, col0 = u.pn * 256 + wc * 32 + 4 * fq;
#pragma unroll
        for (int ai = 0; ai < 2; ++ai)
#pragma unroll
            for (int m = 0; m < 4; ++m) { const size_t off = (size_t)(row0 + ai * 128 + m * 16) * 1024 + col0;
#pragma unroll
                for (int bj = 0; bj < 2; ++bj)
#pragma unroll
                    for (int n = 0; n < 2; ++n) { const f32x4 xv = *(const f32x4*)(x + off + bj * 128 + n * 16);
                        *(f32x4*)(out + off + bj * 128 + n * 16) = xv * 1.189207115002721f + acc[ai][bj][m][n]; } }
    }
};

struct OrderOut {
    int vcu, G;
    __device__ __forceinline__ bool next(int i, Unit& u) const { const int tile = vcu + G * (i >> 1); if (tile >= 512) return false; u.pm = tile >> 2; u.pn = (tile & 3) + 4 * (i & 1); return true; }
    __device__ __forceinline__ const char* aptr(const Gemm& g, const Unit& u, size_t tstep) const { return (const char*)(u.pn >= 4 ? g.A2 : g.A) + (size_t)u.pm * tstep; }
    __device__ __forceinline__ const char* bptr(const Gemm& g, const Unit& u, size_t tstep) const { return (const char*)g.Bt + (size_t)u.pn * tstep; }
    __device__ __forceinline__ void a_ready(const Unit&) const {}
    __device__ __forceinline__ void done(const Unit&) const {}
};
struct OrderRes {
    int vcu, G;
    __device__ __forceinline__ bool next(int i, Unit& u) const { const int tile = vcu + G * i; if (tile >= 512) return false; u.pm = tile >> 2; u.pn = tile & 3; return true; }
    __device__ __forceinline__ const char* aptr(const Gemm& g, const Unit& u, size_t tstep) const { return (const char*)g.A + (size_t)u.pm * tstep; }
    __device__ __forceinline__ const char* bptr(const Gemm& g, const Unit& u, size_t tstep) const { return (const char*)g.Bt + (size_t)u.pn * tstep; }
    __device__ __forceinline__ void a_ready(const Unit&) const {}
    __device__ __forceinline__ void done(const Unit&) const {}
};

template <class Epi, class Sched, bool ALIGN_EPI = false, bool SP2 = false>
__device__ __forceinline__ void gemm_phase(PG8_LAS unsigned char* lds, const Gemm g, const Sched& S, const Epi& E) {
    const int tid = threadIdx.x, wid = __builtin_amdgcn_readfirstlane(tid >> 6), lane = tid & 63, wr = wid >> 2, wc = wid & 3, fr = lane & 15, fq = lane >> 4;
    const int K = g.K, nt = K / BK;
    unsigned voffA[2], voffB[2];
#pragma unroll
    for (int i = 0; i < 2; ++i) { int R, C; stage_rc(tid * 16 + i * 8192, R, C); const int Rb = Epi::PERM ? ((R & ~31) + perm32(R & 31)) : R;
        voffA[i] = (unsigned)(R * K + C) * 2u; voffB[i] = (unsigned)(Rb * K + C) * 2u; }
    const size_t kstep = (size_t)(BK * 2);
    const size_t hstep = (size_t)HALF * K * 2;
    const size_t tstep = 2 * hstep;
    const unsigned ldsw = (unsigned)wid * 1024u;
    const int aoff = lds_byte(wr * 64 + fr, fq * 8), boff = lds_byte(wc * 32 + fr, fq * 8);
#define PG8_SA(b, h) (((b) * 2 + (h)) * HTB)
#define PG8_SB(b, h) ((4 + (b) * 2 + (h)) * HTB)
#define PG8_STAGE(bufoff, gbase, voff) do { _Pragma("unroll") for (int _i = 0; _i < 2; ++_i) \
        __builtin_amdgcn_global_load_lds((const unsigned*)((const char*)(gbase) + (voff)[_i]), (PG8_LAS unsigned*)(lds + (bufoff) + ldsw + _i * 8192), 16, 0, 0); } while (0)
#define PG8_LDA(dst, b, h) do { _Pragma("unroll") for (int m = 0; m < 4; ++m) _Pragma("unroll") for (int k = 0; k < 2; ++k) dst[m][k] = *(const PG8_LAS bf16x8*)(lds + PG8_SA(b, h) + aoff + m * 2048 + k * 1024); } while (0)
#define PG8_LDB(dst, b, h) do { _Pragma("unroll") for (int n = 0; n < 2; ++n) _Pragma("unroll") for (int k = 0; k < 2; ++k) dst[n][k] = *(const PG8_LAS bf16x8*)(lds + PG8_SB(b, h) + boff + n * 2048 + k * 1024); } while (0)
#define PG8_MMA(ai, bj, At, Bt) do { __builtin_amdgcn_s_setprio(1); _Pragma("unroll") for (int m = 0; m < 4; ++m) _Pragma("unroll") for (int n = 0; n < 2; ++n) _Pragma("unroll") for (int k = 0; k < 2; ++k) \
        acc[ai][bj][m][n] = __builtin_amdgcn_mfma_f32_16x16x32_bf16(Bt[n][k], At[m][k], acc[ai][bj][m][n], 0, 0, 0); __builtin_amdgcn_s_setprio(0); } while (0)
#define PG8_WAIT_V(n) asm volatile("s_waitcnt vmcnt(" #n ")" ::: "memory")
#define PG8_WAIT_L(n) asm volatile("s_waitcnt lgkmcnt(" #n ")" ::: "memory")
#define PG8_BAR __builtin_amdgcn_s_barrier()
#define PG8_SCHED __builtin_amdgcn_sched_barrier(0)
    Unit cur, nxt; int ui = 0;
    if (!S.next(0, cur)) return;
    f32x4 acc[2][2][4][2];
#pragma unroll
    for (int a = 0; a < 2; ++a)
#pragma unroll
        for (int b = 0; b < 2; ++b)
#pragma unroll
            for (int m = 0; m < 4; ++m)
#pragma unroll
                for (int n = 0; n < 2; ++n) acc[a][b][m][n] = (f32x4){0.f, 0.f, 0.f, 0.f};
    bf16x8 At[4][2], B0[2][2], B1[2][2];
    const char* cA = S.aptr(g, cur, tstep); const char* cB = S.bptr(g, cur, tstep);
    S.a_ready(cur);
    if constexpr (SP2) {
        PG8_STAGE(PG8_SB(0, 0), cB, voffB); PG8_STAGE(PG8_SB(0, 1), cB + hstep, voffB); PG8_STAGE(PG8_SA(0, 0), cA, voffA); PG8_STAGE(PG8_SA(0, 1), cA + hstep, voffA);
        if (wr == 1) PG8_BAR;
        PG8_WAIT_V(2); PG8_BAR;
        PG8_STAGE(PG8_SB(1, 0), cB + kstep, voffB); PG8_STAGE(PG8_SA(1, 0), cA + kstep, voffA); PG8_STAGE(PG8_SB(1, 1), cB + hstep + kstep, voffB);
        PG8_WAIT_V(6); PG8_BAR;
    } else {
        PG8_STAGE(PG8_SB(0, 0), cB, voffB); PG8_STAGE(PG8_SA(0, 0), cA, voffA); PG8_STAGE(PG8_SB(0, 1), cB + hstep, voffB); PG8_STAGE(PG8_SA(0, 1), cA + hstep, voffA);
        if (wr == 1) PG8_BAR;
        PG8_WAIT_V(4); PG8_BAR;
        PG8_STAGE(PG8_SB(1, 0), cB + kstep, voffB); PG8_STAGE(PG8_SA(1, 0), cA + kstep, voffA); PG8_STAGE(PG8_SB(1, 1), cB + hstep + kstep, voffB);
        PG8_WAIT_V(6); PG8_BAR;
    }
    for (;;) {
        const bool has_next = S.next(ui + 1, nxt);
        const char* nA = has_next ? S.aptr(g, nxt, tstep) : cA; const char* nB = has_next ? S.bptr(g, nxt, tstep) : cB;
        for (int t = 0; t < nt; t += 2) {
            const bool last = (t == nt - 2);
            const char* a1 = cA + (size_t)(t + 1) * kstep;
            const char* a2 = last ? nA : cA + (size_t)(t + 2) * kstep; const char* b2 = last ? nB : cB + (size_t)(t + 2) * kstep;
            const char* a3 = a2 + kstep; const char* b3 = b2 + kstep;
            if (last && has_next) S.a_ready(nxt);
            if constexpr (SP2) {
            PG8_LDB(B0, 0, 0); PG8_LDB(B1, 0, 1); PG8_SCHED; PG8_LDA(At, 0, 0); PG8_STAGE(PG8_SA(1, 1), a1 + hstep, voffA);
            PG8_WAIT_V(8); PG8_WAIT_L(0); PG8_BAR; PG8_MMA(0, 0, At, B0); PG8_MMA(0, 1, At, B1); PG8_BAR; PG8_SCHED;
            PG8_LDA(At, 0, 1); PG8_STAGE(PG8_SB(0, 0), b2, voffB); PG8_STAGE(PG8_SB(0, 1), b2 + hstep, voffB); PG8_STAGE(PG8_SA(0, 0), a2, voffA);
            PG8_WAIT_V(8); PG8_WAIT_L(0); PG8_BAR; PG8_MMA(1, 0, At, B0); PG8_MMA(1, 1, At, B1); PG8_BAR; PG8_SCHED;
            PG8_LDB(B0, 1, 0); PG8_LDB(B1, 1, 1); PG8_SCHED; PG8_LDA(At, 1, 0); PG8_STAGE(PG8_SA(0, 1), a2 + hstep, voffA);
            PG8_WAIT_V(8); PG8_WAIT_L(0); PG8_BAR; PG8_MMA(0, 0, At, B0); PG8_MMA(0, 1, At, B1); PG8_BAR; PG8_SCHED;
            PG8_LDA(At, 1, 1); PG8_STAGE(PG8_SB(1, 0), b3, voffB); PG8_STAGE(PG8_SB(1, 1), b3 + hstep, voffB); PG8_STAGE(PG8_SA(1, 0), a3, voffA);
            PG8_WAIT_V(8); PG8_WAIT_L(0); PG8_BAR; PG8_MMA(1, 0, At, B0); PG8_MMA(1, 1, At, B1); PG8_BAR; PG8_SCHED;
            } else {
            PG8_LDB(B0, 0, 0); PG8_SCHED; PG8_LDA(At, 0, 0); PG8_STAGE(PG8_SA(1, 1), a1 + hstep, voffA);
            PG8_WAIT_L(8); PG8_BAR; PG8_WAIT_L(0); PG8_MMA(0, 0, At, B0); PG8_BAR; PG8_SCHED;
            PG8_LDB(B1, 0, 1); PG8_STAGE(PG8_SB(0, 0), b2, voffB);
            PG8_BAR; PG8_WAIT_L(0); PG8_MMA(0, 1, At, B1); PG8_BAR;
            PG8_LDA(At, 0, 1); PG8_STAGE(PG8_SA(0, 0), a2, voffA);
            PG8_BAR; PG8_WAIT_L(0); PG8_MMA(1, 0, At, B0); PG8_BAR; PG8_SCHED;
            PG8_STAGE(PG8_SB(0, 1), b2 + hstep, voffB);
            PG8_WAIT_V(6); PG8_BAR; PG8_MMA(1, 1, At, B1); PG8_BAR;
            PG8_LDB(B0, 1, 0); PG8_SCHED; PG8_LDA(At, 1, 0); PG8_STAGE(PG8_SA(0, 1), a2 + hstep, voffA);
            PG8_WAIT_L(8); PG8_BAR; PG8_WAIT_L(0); PG8_MMA(0, 0, At, B0); PG8_BAR; PG8_SCHED;
            PG8_LDB(B1, 1, 1); PG8_STAGE(PG8_SB(1, 0), b3, voffB);
            PG8_BAR; PG8_WAIT_L(0); PG8_MMA(0, 1, At, B1); PG8_BAR;
            PG8_LDA(At, 1, 1); PG8_STAGE(PG8_SA(1, 0), a3, voffA);
            PG8_BAR; PG8_WAIT_L(0); PG8_MMA(1, 0, At, B0); PG8_BAR; PG8_SCHED;
            PG8_STAGE(PG8_SB(1, 1), b3 + hstep, voffB);
            PG8_WAIT_V(6); PG8_BAR; PG8_MMA(1, 1, At, B1); PG8_BAR;
            }
        }
        if constexpr (ALIGN_EPI) { if (wr == 0) PG8_BAR; }
        if constexpr (!Epi::AFTER_DRAIN) { E(acc, cur, wr, wc, fr, fq); S.done(cur); }
        if (!has_next) break;
#pragma unroll
        for (int a = 0; a < 2; ++a)
#pragma unroll
            for (int b = 0; b < 2; ++b)
#pragma unroll
                for (int m = 0; m < 4; ++m)
#pragma unroll
                    for (int n = 0; n < 2; ++n) acc[a][b][m][n] = (f32x4){0.f, 0.f, 0.f, 0.f};
        cur = nxt; cA = nA; cB = nB; ++ui;
        if constexpr (ALIGN_EPI) { if (wr == 1) PG8_BAR; }
    }
    PG8_WAIT_V(0);
    if constexpr (!ALIGN_EPI) { if (wr == 0) PG8_BAR; }
    PG8_BAR;
    if constexpr (Epi::AFTER_DRAIN) { E.fused(acc, cur, wr, wc, fr, fq, lds, wid, lane); S.done(cur); }
#undef PG8_SA
#undef PG8_SB
#undef PG8_STAGE
#undef PG8_LDA
#undef PG8_LDB
#undef PG8_MMA
#undef PG8_WAIT_V
#undef PG8_WAIT_L
#undef PG8_BAR
#undef PG8_SCHED
}
}


#define GAS __attribute__((address_space(1)))
#define LAS __attribute__((address_space(3)))
typedef unsigned short bf16;
typedef unsigned v4u __attribute__((ext_vector_type(4)));
typedef unsigned v2u __attribute__((ext_vector_type(2)));
typedef float f32x4 __attribute__((ext_vector_type(4)));
typedef float f32x16 __attribute__((ext_vector_type(16)));
typedef short bf16x8 __attribute__((ext_vector_type(8)));
typedef short s16x4 __attribute__((ext_vector_type(4)));
typedef GAS unsigned gu32;
#define RLX_AGENT __ATOMIC_RELAXED, __HIP_MEMORY_SCOPE_AGENT
#define LDS_WAIT() asm volatile("s_waitcnt lgkmcnt(0)" ::: "memory")
__device__ __forceinline__ unsigned f2bf(float f) { unsigned u = __builtin_bit_cast(unsigned, f); return (u + 0x7fffu + ((u >> 16) & 1u)) >> 16; }
__device__ __forceinline__ unsigned pk2(float lo, float hi) { return f2bf(lo) | (f2bf(hi) << 16); }
__device__ __forceinline__ float bflo(unsigned w) { return __uint_as_float(w << 16); }
__device__ __forceinline__ float bfhi(unsigned w) { return __uint_as_float(w & 0xffff0000u); }

constexpr size_t MiB = 1u << 20;
constexpr size_t WS_CTL = 0, CTL_ZERO_BYTES = 1 * MiB;
constexpr size_t WS_WIN = 1 * MiB;
constexpr size_t WS_WOAB = 12 * MiB;
constexpr size_t WS_WOUT = 14 * MiB;
constexpr size_t WS_KPART = 16 * MiB;
constexpr size_t WS_SEL = 17 * MiB;
constexpr size_t WS_XB = 20 * MiB;
constexpr size_t WS_YA = 20 * MiB, WS_YB = 52 * MiB;
constexpr size_t WS_QKZ = 84 * MiB;
constexpr size_t WS_T = 84 * MiB;
constexpr size_t WS_G = 252 * MiB;
constexpr size_t WS_VT = 380 * MiB;
constexpr size_t WS_MRG = 420 * MiB;
constexpr size_t WS_PML = 484 * MiB;
constexpr size_t WS_END = 492 * MiB;
constexpr int CW_Q3 = 64;
constexpr int CW_BAR = 4096;

#define XB_TMO      128
#define XB_XCNT(j)  (256  + 64 * (j))
#define XB_XSUB(j)  (1280 + 64 * (j))
#define XB_XGEN(j)  (2304 + 64 * (j))
#define XB_TOP      3328
#define XB_TOPGEN   3392
#define XCD_BAR_WORDS 3456
#define XB_SPIN_CAP (1u << 18)

__device__ __forceinline__ unsigned xb_ld(unsigned* p)              { return __hip_atomic_load(p, __ATOMIC_RELAXED, __HIP_MEMORY_SCOPE_AGENT); }
__device__ __forceinline__ unsigned xb_add(unsigned* p, unsigned v) { return __hip_atomic_fetch_add(p, v, __ATOMIC_RELAXED, __HIP_MEMORY_SCOPE_AGENT); }
__device__ __forceinline__ unsigned xb_xcc_id() { return (unsigned)__builtin_amdgcn_s_getreg((3 << 11) | 20) & 0xFu; }
#define XB_SPIN(cond, bar) do { unsigned _sp = 0; while (cond) { __builtin_amdgcn_s_sleep(1); \
    if ((++_sp & 255u) == 0u) { if (xb_ld(&(bar)[XB_TMO])) break; if (_sp > XB_SPIN_CAP) { atomicAdd(&(bar)[XB_TMO], 1u); break; } } } } while (0)

struct XcdBarrier {
    unsigned* bar; unsigned x;
    volatile LAS unsigned* st;
};

__device__ __forceinline__ XcdBarrier xcd_barrier_post(unsigned* bar, volatile LAS unsigned* st) {
    XcdBarrier b; b.bar = bar; b.x = xb_xcc_id(); b.st = st;
    if (threadIdx.x == 0) (void)xb_add(&bar[XB_XCNT(b.x)], 1u);
    return b;
}
__device__ __forceinline__ void xcd_barrier_complete(unsigned* bar, unsigned x, unsigned& nloc, unsigned& nx) {
    const unsigned G = gridDim.x * gridDim.y * gridDim.z;
    unsigned sum, cnt, mine, sp = 0u;
    for (;;) {
        sum = 0u; cnt = 0u; mine = 0u;
#pragma unroll
        for (unsigned j = 0; j < 16; ++j) { const unsigned c = xb_ld(&bar[XB_XCNT(j)]); sum += c; cnt += (c > 0u) ? 1u : 0u; mine = (j == x) ? c : mine; }
        if (sum == G) break;
        __builtin_amdgcn_s_sleep(1);
        if ((++sp & 255u) == 0u) { if (xb_ld(&bar[XB_TMO])) break; if (sp > XB_SPIN_CAP) { atomicAdd(&bar[XB_TMO], 1u); break; } }
    }
    nloc = mine > 0u ? mine : 1u; nx = cnt > 0u ? cnt : 1u;
}

__device__ __forceinline__ void xcd_barrier(const XcdBarrier& b) {
    asm volatile("s_waitcnt vmcnt(0)" ::: "memory");
    __syncthreads();
    if (threadIdx.x == 0) {
        unsigned* bar = b.bar;
        __builtin_amdgcn_s_waitcnt(0);
        unsigned nloc = b.st[0], nx = b.st[1];
        if (nloc == 0u) { xcd_barrier_complete(bar, b.x, nloc, nx); b.st[0] = nloc; b.st[1] = nx; }
        const unsigned old = xb_add(&bar[XB_XSUB(b.x)], 1u);
        const unsigned gen = old / nloc;
        if (old + 1u == (gen + 1u) * nloc) {
            __builtin_amdgcn_fence(__ATOMIC_RELEASE, "agent");
            asm volatile("s_waitcnt vmcnt(0)" ::: "memory");
            const unsigned og = xb_add(&bar[XB_TOP], 1u);
            const unsigned tg = og / nx;
            if (og + 1u == (tg + 1u) * nx) xb_add(&bar[XB_TOPGEN], 1u);
            else XB_SPIN(xb_ld(&bar[XB_TOPGEN]) == tg, bar);
            __builtin_amdgcn_fence(__ATOMIC_ACQUIRE, "agent");
            xb_add(&bar[XB_XGEN(b.x)], 1u);
            asm volatile("s_waitcnt vmcnt(0)" ::: "memory");
        } else {
            XB_SPIN(xb_ld(&bar[XB_XGEN(b.x)]) == gen, bar);
            __builtin_amdgcn_fence(__ATOMIC_ACQUIRE, "agent");
            asm volatile("s_waitcnt vmcnt(0)" ::: "memory");
        }
    }
    __syncthreads();
}

constexpr int RING_BYTES = 131072;
constexpr int LDSCTL_OFF = RING_BYTES, MISC_OFF = LDSCTL_OFF + 320;
constexpr int LDS_BYTES = 147456;
constexpr int NWAVES = 8;

struct Frame {
    LAS unsigned char* lds;
    volatile LAS unsigned* MISC;
    gu32* ctl;
    int tid, lane, wave, vcu, G;
    const float *x, *w_in, *b_gate, *sinks, *rel, *w_oa, *w_ob, *w_out, *gamma, *beta;
    float* out;
    bf16 *WinT, *WoabT, *WoutT, *XB, *YA, *YB, *QKZ, *GB, *VT, *MRG, *PO;
    float *kpart, *PML; bf16* T; unsigned* SEL;
};

__device__ __forceinline__ void p0_transpose_item(const float* W, int K, int N, bf16* WT, int row_off, LAS float* scr, int item, int lane) {
    const int nblk = N / 32, kb = item / nblk, nb = item % nblk, k0 = 64 * kb, n0 = 32 * nb;
#pragma unroll 8
    for (int i = 0; i < 32; ++i) { const int kk = 2 * i + (lane >> 5); scr[kk * 33 + (lane & 31)] = W[(size_t)(k0 + kk) * N + n0 + (lane & 31)]; }
    LDS_WAIT(); asm volatile("" ::: "memory");
    const int c = lane & 7;
#pragma unroll
    for (int j = 0; j < 4; ++j) { const int n = (lane >> 3) + 8 * j; const LAS float* s = scr + (8 * c) * 33 + n;
        v4u o; o.x = pk2(s[0 * 33], s[1 * 33]); o.y = pk2(s[2 * 33], s[3 * 33]); o.z = pk2(s[4 * 33], s[5 * 33]); o.w = pk2(s[6 * 33], s[7 * 33]);
        *(GAS v4u*)(WT + (size_t)(row_off + n0 + n) * K + k0 + 8 * c) = o; }
    LDS_WAIT(); asm volatile("" ::: "memory");
}
__device__ __forceinline__ void p0_prologue(Frame& F) {
    LAS float* scr = (LAS float*)(F.lds + F.wave * 16384);
    const int gw = F.vcu * NWAVES + F.wave, NGW = F.G * NWAVES;
    constexpr int I_IN = (1024 / 64) * (NIN / 32), I_OA = (512 / 64) * (1024 / 32), I_OUT = (1024 / 64) * (1024 / 32);
    constexpr int NITEMS = I_IN + 2 * I_OA + I_OUT;
    for (int it = gw; it < NITEMS; it += NGW) {
        int r = it;
        if (r < I_IN) { p0_transpose_item(F.w_in, 1024, NIN, F.WinT, 0, scr, r, F.lane); continue; } r -= I_IN;
        if (r < I_OA) { p0_transpose_item(F.w_oa, 512, 1024, F.WoabT, 0, scr, r, F.lane); continue; } r -= I_OA;
        if (r < I_OA) { p0_transpose_item(F.w_ob, 512, 1024, F.WoabT, 1024, scr, r, F.lane); continue; } r -= I_OA;
        p0_transpose_item(F.w_out, 1024, 1024, F.WoutT, 0, scr, r, F.lane);
    }
    const size_t nchunk = (size_t)MTOK * DM / 8;
    for (size_t c = (size_t)blockIdx.x * 512 + F.tid; c < nchunk; c += (size_t)F.G * 512) {
        const f32x4 a = *(const GAS f32x4*)(F.x + c * 8), b = *(const GAS f32x4*)(F.x + c * 8 + 4);
        v4u o; o.x = pk2(a.x, a.y); o.y = pk2(a.z, a.w); o.z = pk2(b.x, b.y); o.w = pk2(b.z, b.w);
        *(GAS v4u*)(F.XB + c * 8) = o;
    }
}

__device__ __forceinline__ unsigned cvtpk(float lo, float hi) { typedef float f2 __attribute__((ext_vector_type(2))); typedef __bf16 b2 __attribute__((ext_vector_type(2))); f2 v = {lo, hi}; b2 b = __builtin_convertvector(v, b2); return __builtin_bit_cast(unsigned, b); }
__device__ __forceinline__ float ex2(float v) { return __builtin_amdgcn_exp2f(v); }
__device__ __forceinline__ float xhalf_max(float m) { auto rr = __builtin_amdgcn_permlane32_swap(__float_as_uint(m), __float_as_uint(m), false, false); return fmaxf(__uint_as_float(rr[0]), __uint_as_float(rr[1])); }
__device__ __forceinline__ float xhalf_sum(float m) { auto rr = __builtin_amdgcn_permlane32_swap(__float_as_uint(m), __float_as_uint(m), false, false); return __uint_as_float(rr[0]) + __uint_as_float(rr[1]); }
struct AttSt { f32x16 o0, o1; float m, l; };
__device__ __forceinline__ void att_init(AttSt& st) { st.o0 = f32x16{}; st.o1 = f32x16{}; st.m = -1e30f; st.l = 0.f; }
template <int MASK> __device__ __forceinline__ void bias_mask(f32x16& s, const LAS float* tab, int dbase, float sub) {
#pragma unroll
    for (int r = 0; r < 16; ++r) { const int d = dbase - ((r & 3) + 8 * (r >> 2)); const int di = d < 0 ? 0 : (d > 127 ? 127 : d);
        float v = s[r] + (tab[di] - sub);
        if (MASK == 1) v = d < 0 ? -INFINITY : v;
        if (MASK == 2) v = (d < 0 || d >= 128) ? -INFINITY : v;
        s[r] = v; }
}
__device__ __forceinline__ void softmax_pv(AttSt& st, f32x16& s, const bf16x8 (&vf)[2][2]) {
    float mt = fmaxf(s[0], s[1]);
#pragma unroll
    for (int r = 2; r < 16; ++r) mt = fmaxf(mt, s[r]);
    mt = xhalf_max(mt);
    const float mn = fmaxf(st.m, mt), alpha = ex2(st.m - mn);
    float sum = 0.f;
#pragma unroll
    for (int r = 0; r < 16; ++r) { s[r] = ex2(s[r] - mn); sum += s[r]; }
    st.l = st.l * alpha + sum; st.m = mn;
    st.o0 = st.o0 * alpha; st.o1 = st.o1 * alpha;
    v4u pw0, pw1;
    pw0.x = cvtpk(s[0], s[1]); pw0.y = cvtpk(s[2], s[3]); pw0.z = cvtpk(s[4], s[5]); pw0.w = cvtpk(s[6], s[7]);
    pw1.x = cvtpk(s[8], s[9]); pw1.y = cvtpk(s[10], s[11]); pw1.z = cvtpk(s[12], s[13]); pw1.w = cvtpk(s[14], s[15]);
    const bf16x8 p0 = __builtin_bit_cast(bf16x8, pw0), p1 = __builtin_bit_cast(bf16x8, pw1);
    st.o0 = __builtin_amdgcn_mfma_f32_32x32x16_bf16(vf[0][0], p0, st.o0, 0, 0, 0);
    st.o0 = __builtin_amdgcn_mfma_f32_32x32x16_bf16(vf[0][1], p1, st.o0, 0, 0, 0);
    st.o1 = __builtin_amdgcn_mfma_f32_32x32x16_bf16(vf[1][0], p0, st.o1, 0, 0, 0);
    st.o1 = __builtin_amdgcn_mfma_f32_32x32x16_bf16(vf[1][1], p1, st.o1, 0, 0, 0);
}
template <int MASK> __device__ __forceinline__ void tile_global(AttSt& st, const bf16x8 (&qf)[4], const bf16* Kg, const bf16* VTg, const LAS float* tab, int dbase, int lane) {
    const int r32 = lane & 31, hh = lane >> 5;
    bf16x8 kf[4], vf[2][2];
#pragma unroll
    for (int d0 = 0; d0 < 4; ++d0) kf[d0] = *(const GAS bf16x8*)(Kg + (size_t)r32 * QKZ_LD + 16 * d0 + 8 * hh);
#pragma unroll
    for (int dt = 0; dt < 2; ++dt)
#pragma unroll
        for (int s2 = 0; s2 < 2; ++s2) { const bf16* p = VTg + (size_t)(32 * dt + r32) * SEQ + 16 * s2 + 4 * hh;
            const s16x4 lo = *(const GAS s16x4*)p, hi = *(const GAS s16x4*)(p + 8);
            vf[dt][s2] = (bf16x8){lo[0], lo[1], lo[2], lo[3], hi[0], hi[1], hi[2], hi[3]}; }
    f32x16 s = f32x16{};
#pragma unroll
    for (int d0 = 0; d0 < 4; ++d0) s = __builtin_amdgcn_mfma_f32_32x32x16_bf16(kf[d0], qf[d0], s, 0, 0, 0);
    bias_mask<MASK>(s, tab, dbase, 0.f);
    softmax_pv(st, s, vf);
}
__device__ __forceinline__ int t5_bucket(int n) {
    if (n < 16) return n;
    const int large = 16 + (int)(logf((float)n / 16.0f) / 2.0794415416798357f * 16.0f);
    return large < 31 ? large : 31;
}
__device__ __forceinline__ void fill_tab(LAS float* tab, const float* rel, int col, int tid) {
    if (tid < 128) tab[tid] = rel[t5_bucket(tid) * 16 + col] * LOG2E;
}

__device__ __forceinline__ void gate_unit(Frame& F, int b, int h, int u) {
    LAS float* km = (LAS float*)F.lds;
    const int nk = 2 * u + 1;
    __syncthreads();
    for (int idx = F.tid; idx < nk * 64; idx += 512) { const int n = idx >> 6, d = idx & 63; const size_t pm = (size_t)(b * 32 + n);
        km[idx] = (F.kpart[(pm * 2) * 512 + h * 64 + d] + F.kpart[(pm * 2 + 1) * 512 + h * 64 + d]) * (1.0f / 256.0f); }
    __syncthreads();
    const int t = 512 * u + F.tid, j = t >> 8;
    const bf16* qp = F.QKZ + (size_t)(b * SEQ + t) * QKZ_LD + QB_OFF + h * 64;
    float q[64];
#pragma unroll
    for (int c = 0; c < 8; ++c) { const v4u w = *(const GAS v4u*)(qp + 8 * c);
        q[8 * c + 0] = bflo(w.x); q[8 * c + 1] = bfhi(w.x); q[8 * c + 2] = bflo(w.y); q[8 * c + 3] = bfhi(w.y);
        q[8 * c + 4] = bflo(w.z); q[8 * c + 5] = bfhi(w.z); q[8 * c + 6] = bflo(w.w); q[8 * c + 7] = bfhi(w.w); }
    float v0 = -INFINITY, v1 = -INFINITY, v2 = -INFINITY; unsigned i0 = 0xffu, i1 = 0xffu, i2 = 0xffu;
    for (int n = 0; n < j; ++n) {
        const LAS f32x4* kp = (const LAS f32x4*)(km + n * 64);
        float g0 = 0.f, g1 = 0.f;
#pragma unroll
        for (int c = 0; c < 16; c += 2) { const f32x4 a = kp[c], bb = kp[c + 1];
            g0 += q[4 * c] * a.x + q[4 * c + 1] * a.y + q[4 * c + 2] * a.z + q[4 * c + 3] * a.w;
            g1 += q[4 * c + 4] * bb.x + q[4 * c + 5] * bb.y + q[4 * c + 6] * bb.z + q[4 * c + 7] * bb.w; }
        const float g = g0 + g1;
        if (g > v0) { v2 = v1; i2 = i1; v1 = v0; i1 = i0; v0 = g; i0 = (unsigned)n; }
        else if (g > v1) { v2 = v1; i2 = i1; v1 = g; i1 = (unsigned)n; }
        else if (g > v2) { v2 = g; i2 = (unsigned)n; }
    }
    F.SEL[(size_t)(b * 8 + h) * SEQ + t] = i0 | (i1 << 8) | (i2 << 16);
}

constexpr int SEL_K_OFF = 0, SEL_KP = 144;
constexpr int SEL_V_OFF = 36864, SEL_VP = 520;
constexpr int SEL_TAB_OFF = 70144, SEL_Q_OFF = 70656;
template <int VP> __device__ __forceinline__ void tile_lds_qk(f32x16& s, bf16x8 (&vf)[2][2], const bf16x8 (&qf)[4], const LAS unsigned char* kp, const LAS unsigned char* vp) {
    bf16x8 kf[4];
#pragma unroll
    for (int d0 = 0; d0 < 4; ++d0) kf[d0] = *(const LAS bf16x8*)(kp + 32 * d0);
#pragma unroll
    for (int dt = 0; dt < 2; ++dt)
#pragma unroll
        for (int s2 = 0; s2 < 2; ++s2) { const LAS unsigned char* p = vp + dt * 32 * VP + 32 * s2;
            const s16x4 lo = *(const LAS s16x4*)p, hi = *(const LAS s16x4*)(p + 16);
            vf[dt][s2] = (bf16x8){lo[0], lo[1], lo[2], lo[3], hi[0], hi[1], hi[2], hi[3]}; }
    s = f32x16{};
#pragma unroll
    for (int d0 = 0; d0 < 4; ++d0) s = __builtin_amdgcn_mfma_f32_32x32x16_bf16(kf[d0], qf[d0], s, 0, 0, 0);
}
__device__ __forceinline__ void blk_tiles(Frame& F, AttSt& st, const bf16x8 (&qf)[4], int t, int n, int nkt, bool causal_last) {
    const int lane = F.lane, r32 = lane & 31, hh = lane >> 5;
    const LAS float* tab = (const LAS float*)(F.lds + SEL_TAB_OFF);
    const float t127 = tab[127];
    const LAS unsigned char* kb = F.lds + SEL_K_OFF + r32 * SEL_KP + 16 * hh;
    const LAS unsigned char* vb = F.lds + SEL_V_OFF + r32 * SEL_VP + 8 * hh;
#pragma unroll 1
    for (int kt = 0; kt < nkt; ++kt) {
        f32x16 s; bf16x8 vf[2][2];
        tile_lds_qk<SEL_VP>(s, vf, qf, kb + kt * 32 * SEL_KP, vb + kt * 64);
        const int key0 = 256 * n + 32 * kt;
        if (causal_last && kt == nkt - 1) bias_mask<1>(s, tab, t - key0 - 4 * hh, t127);
        else if (__any((t - (key0 + 31)) < 113)) bias_mask<0>(s, tab, t - key0 - 4 * hh, t127);
        softmax_pv(st, s, vf);
    }
}
__device__ __forceinline__ void write_partial(Frame& F, const AttSt& st, float madd, size_t row, int h, int slot, bool valid) {
    const int hh = F.lane >> 5;
    const float l = xhalf_sum(st.l);
    if (valid) {
        const size_t pidx = (row * 8 + h) * 4 + slot;
        v4u w0, w1, w2, w3;
        w0.x = cvtpk(st.o0[0], st.o0[1]); w0.y = cvtpk(st.o0[2], st.o0[3]); w0.z = cvtpk(st.o0[4], st.o0[5]); w0.w = cvtpk(st.o0[6], st.o0[7]);
        w1.x = cvtpk(st.o0[8], st.o0[9]); w1.y = cvtpk(st.o0[10], st.o0[11]); w1.z = cvtpk(st.o0[12], st.o0[13]); w1.w = cvtpk(st.o0[14], st.o0[15]);
        w2.x = cvtpk(st.o1[0], st.o1[1]); w2.y = cvtpk(st.o1[2], st.o1[3]); w2.z = cvtpk(st.o1[4], st.o1[5]); w2.w = cvtpk(st.o1[6], st.o1[7]);
        w3.x = cvtpk(st.o1[8], st.o1[9]); w3.y = cvtpk(st.o1[10], st.o1[11]); w3.z = cvtpk(st.o1[12], st.o1[13]); w3.w = cvtpk(st.o1[14], st.o1[15]);
        GAS v4u* po = (GAS v4u*)(F.PO + pidx * 64 + hh * 32);
        po[0] = w0; po[1] = w1; po[2] = w2; po[3] = w3;
        if (hh == 0) { typedef float f2 __attribute__((ext_vector_type(2))); *(GAS f2*)(F.PML + pidx * 2) = (f2){st.m + madd, l}; }
    }
}
__device__ __forceinline__ void load_q(bf16x8 (&qf)[4], const bf16* qp) {
#pragma unroll
    for (int d0 = 0; d0 < 4; ++d0) qf[d0] = *(const GAS bf16x8*)(qp + 16 * d0);
}
__device__ __forceinline__ void sel_unit(Frame& F, int b, int h, int n) {
    const int tid = F.tid, lane = F.lane, wid = F.wave, r32 = lane & 31, hh = lane >> 5;
    const bf16* Kg = F.QKZ + (size_t)(b * SEQ + 256 * n) * QKZ_LD + KB_OFF + h * 64;
    const bf16* Vg = F.VT + (size_t)(b * NVH + 2 + h) * 64 * SEQ + 256 * n;
#pragma unroll
    for (int i = 0; i < 4; ++i) { const int idx = tid + 512 * i, key = idx >> 3, ch = idx & 7;
        const v4u v = *(const GAS v4u*)(Kg + (size_t)key * QKZ_LD + ch * 8);
        *(LAS v4u*)(F.lds + SEL_K_OFF + key * SEL_KP + ch * 16) = v; }
#pragma unroll
    for (int i = 0; i < 4; ++i) { const int idx = tid + 512 * i, d = idx >> 5, ch = idx & 31;
        const v4u v = *(const GAS v4u*)(Vg + (size_t)d * SEQ + ch * 8);
        LAS v2u* p = (LAS v2u*)(F.lds + SEL_V_OFF + d * SEL_VP + ch * 16); p[0] = (v2u){v.x, v.y}; p[1] = (v2u){v.z, v.w}; }
    fill_tab((LAS float*)(F.lds + SEL_TAB_OFF), F.rel, 8 + h, tid);
    const int town = 256 * n + 32 * wid + r32;
    bf16x8 qf[4];
    load_q(qf, F.QKZ + (size_t)(b * SEQ + town) * QKZ_LD + QB_OFF + h * 64 + 8 * hh);
    __syncthreads();
    const float t127 = ((const LAS float*)(F.lds + SEL_TAB_OFF))[127];
    { AttSt st; att_init(st);
      blk_tiles(F, st, qf, town, n, wid + 1, true);
      write_partial(F, st, t127, (size_t)(b * SEQ + town), h, 3, true); }
    if (n == 31) return;
    LAS unsigned* queue = (LAS unsigned*)(F.lds + SEL_Q_OFF) + wid * 128;
    const unsigned* selp = F.SEL + (size_t)(b * 8 + h) * SEQ;
    const int nchunks = 4 * (31 - n);
    unsigned head = 0; int cnt = 0;
    for (int c = wid;; c += NWAVES) {
        const bool more = c < nchunks;
        if (more) {
            const int t = 256 * (n + 1) + 64 * c + lane;
            const unsigned sel = selp[t];
            const int slot = ((sel & 0xffu) == (unsigned)n) ? 0 : (((sel >> 8) & 0xffu) == (unsigned)n) ? 1 : (((sel >> 16) & 0xffu) == (unsigned)n) ? 2 : -1;
            const unsigned long long mask = __ballot(slot >= 0);
            if (slot >= 0) { const int pos = __builtin_amdgcn_mbcnt_hi((unsigned)(mask >> 32), __builtin_amdgcn_mbcnt_lo((unsigned)mask, 0u));
                queue[(head + (unsigned)(cnt + pos)) & 127u] = (unsigned)t | ((unsigned)slot << 16); }
            cnt += __builtin_popcountll(mask);
            LDS_WAIT(); asm volatile("" ::: "memory");
        }
#pragma unroll 1
        while (cnt >= 32 || (!more && cnt > 0)) { const int nv = cnt < 32 ? cnt : 32;
            const unsigned e = queue[(head + (unsigned)(r32 < nv ? r32 : nv - 1)) & 127u];
            const int t = (int)(e & 0xffffu), slot = (int)(e >> 16);
            const size_t row = (size_t)(b * SEQ + t);
            load_q(qf, F.QKZ + row * QKZ_LD + QB_OFF + h * 64 + 8 * hh);
            AttSt st; att_init(st);
            blk_tiles(F, st, qf, t, n, 8, false);
            write_partial(F, st, t127, row, h, slot, r32 < nv);
            head = (head + (unsigned)nv) & 127u; cnt -= nv; }
        if (!more) break;
    }
}

constexpr int SWA_K_OFF = 0, SWA_KP = 144;
constexpr int SWA_V_OFF = 55296, SWA_VP = 776;
constexpr int SWA_TAB_OFF = 104960;
__device__ __forceinline__ void swa_unit(Frame& F, int b, int kvh, int blk) {
    const int tid = F.tid, lane = F.lane, wid = F.wave, r32 = lane & 31, hh = lane >> 5;
    const int klo = 256 * blk - 128;
    const bf16* Kg = F.QKZ + (size_t)b * SEQ * QKZ_LD + KA_OFF + kvh * 64;
    const bf16* Vg = F.VT + (size_t)(b * NVH + kvh) * 64 * SEQ;
#pragma unroll
    for (int i = 0; i < 6; ++i) { const int idx = tid + 512 * i, kr = idx >> 3, ch = idx & 7, key = klo + kr;
        if (key >= 0) { const v4u v = *(const GAS v4u*)(Kg + (size_t)key * QKZ_LD + ch * 8); *(LAS v4u*)(F.lds + SWA_K_OFF + kr * SWA_KP + ch * 16) = v; } }
#pragma unroll
    for (int i = 0; i < 6; ++i) { const int idx = tid + 512 * i, d = idx / 48, ch = idx % 48, key = klo + ch * 8;
        if (key >= 0) { const v4u v = *(const GAS v4u*)(Vg + (size_t)d * SEQ + key);
            LAS v2u* p = (LAS v2u*)(F.lds + SWA_V_OFF + d * SWA_VP + ch * 16); p[0] = (v2u){v.x, v.y}; p[1] = (v2u){v.z, v.w}; } }
    if (tid < 512) { const int g = tid >> 7, dd = tid & 127; ((LAS float*)(F.lds + SWA_TAB_OFF))[tid] = F.rel[t5_bucket(dd) * 16 + kvh * 4 + g] * LOG2E; }
    const int t0 = 256 * blk + 32 * wid, t = t0 + r32;
    const size_t row = (size_t)(b * SEQ + t);
    const bf16* qrow = F.QKZ + row * QKZ_LD + QA_OFF + kvh * 256 + 8 * hh;
    bf16x8 qc[4], qn[4];
    load_q(qc, qrow);
    __syncthreads();
    const LAS unsigned char* kb = F.lds + SWA_K_OFF + (32 * wid + r32) * SWA_KP + 16 * hh;
    const LAS unsigned char* vb = F.lds + SWA_V_OFF + r32 * SWA_VP + 8 * hh + 64 * wid;
#pragma unroll 1
    for (int g = 0; g < 4; ++g) {
        const int a = kvh * 4 + g;
        load_q(qn, qrow + (g < 3 ? g + 1 : g) * 64);
        const LAS float* tab = (const LAS float*)(F.lds + SWA_TAB_OFF) + 128 * g;
        AttSt st; att_init(st);
#pragma unroll 1
        for (int i = (blk == 0 && wid < 4) ? 4 - wid : 0; i < 5; ++i) {
            f32x16 s; bf16x8 vf[2][2];
            tile_lds_qk<SWA_VP>(s, vf, qc, kb + i * 32 * SWA_KP, vb + i * 64);
            const int dbase = 128 - 32 * i + r32 - 4 * hh;
            if (i == 0 || i == 4) bias_mask<2>(s, tab, dbase, 0.f); else bias_mask<0>(s, tab, dbase, 0.f);
            softmax_pv(st, s, vf);
        }
        float l = xhalf_sum(st.l);
        l += ex2(F.sinks[a] * LOG2E - st.m);
        const float inv = 1.0f / l;
        const bf16* zp = F.QKZ + row * QKZ_LD + ZA_OFF + a * 64;
        bf16* yp = F.YA + row * 512 + a * 64;
#pragma unroll
        for (int dt = 0; dt < 2; ++dt)
#pragma unroll
            for (int gg = 0; gg < 4; ++gg) { const int d = 32 * dt + 8 * gg + 4 * hh;
                const v2u z = *(const GAS v2u*)(zp + d);
                const f32x16& o = dt ? st.o1 : st.o0;
                v2u y; y.x = cvtpk(o[4 * gg] * inv * bflo(z.x), o[4 * gg + 1] * inv * bfhi(z.x)); y.y = cvtpk(o[4 * gg + 2] * inv * bflo(z.y), o[4 * gg + 3] * inv * bfhi(z.y));
                *(GAS v2u*)(yp + d) = y; }
#pragma unroll
        for (int d0 = 0; d0 < 4; ++d0) qc[d0] = qn[d0];
    }
}

__device__ __forceinline__ void merge_rows(Frame& F) {
    const int gw = F.vcu * NWAVES + F.wave, NGW = F.G * NWAVES;
    const int h = F.lane >> 3, q = F.lane & 7, dlo = 32 * ((q >> 1) & 1) + 16 * (q & 1) + 4 * (q >> 2);
    for (int row = gw; row < MTOK; row += NGW) {
        const int j = (row & (SEQ - 1)) >> 8, nsel = j < 3 ? j : 3;
        const size_t pb = ((size_t)row * 8 + h) * 4;
        const GAS v4u* po = (const GAS v4u*)(F.PO + pb * 64) + q;
        const v4u ml0 = *(const GAS v4u*)(F.PML + pb * 2), ml1 = *(const GAS v4u*)(F.PML + pb * 2 + 4);
        const v4u o3 = po[24];
        v4u os[3];
#pragma unroll
        for (int s = 0; s < 3; ++s) os[s] = (s < nsel) ? po[8 * s] : (v4u){0u, 0u, 0u, 0u};
        const v2u z0 = *(const GAS v2u*)(F.QKZ + (size_t)row * QKZ_LD + ZB_OFF + h * 64 + dlo), z1 = *(const GAS v2u*)(F.QKZ + (size_t)row * QKZ_LD + ZB_OFF + h * 64 + dlo + 8);
        const float m3 = __uint_as_float(ml1.z), l3 = __uint_as_float(ml1.w);
        float ms[3] = {__uint_as_float(ml0.x), __uint_as_float(ml0.z), __uint_as_float(ml1.x)}, ls[3] = {__uint_as_float(ml0.y), __uint_as_float(ml0.w), __uint_as_float(ml1.y)};
        float M = m3;
#pragma unroll
        for (int s = 0; s < 3; ++s) if (s < nsel) M = fmaxf(M, ms[s]);
        const float w3 = ex2(m3 - M);
        float L = w3 * l3;
        float o[8] = {w3 * bflo(o3.x), w3 * bfhi(o3.x), w3 * bflo(o3.y), w3 * bfhi(o3.y), w3 * bflo(o3.z), w3 * bfhi(o3.z), w3 * bflo(o3.w), w3 * bfhi(o3.w)};
#pragma unroll
        for (int s = 0; s < 3; ++s) if (s < nsel) { const float ws = ex2(ms[s] - M); L += ws * ls[s];
            o[0] += ws * bflo(os[s].x); o[1] += ws * bfhi(os[s].x); o[2] += ws * bflo(os[s].y); o[3] += ws * bfhi(os[s].y);
            o[4] += ws * bflo(os[s].z); o[5] += ws * bfhi(os[s].z); o[6] += ws * bflo(os[s].w); o[7] += ws * bfhi(os[s].w); }
        const float inv = 1.0f / L;
        v2u y0, y1;
        y0.x = cvtpk(o[0] * inv * bflo(z0.x), o[1] * inv * bfhi(z0.x)); y0.y = cvtpk(o[2] * inv * bflo(z0.y), o[3] * inv * bfhi(z0.y));
        y1.x = cvtpk(o[4] * inv * bflo(z1.x), o[5] * inv * bfhi(z1.x)); y1.y = cvtpk(o[6] * inv * bflo(z1.y), o[7] * inv * bfhi(z1.y));
        bf16* yp = F.YB + (size_t)row * 512 + h * 64 + dlo;
        *(GAS v2u*)yp = y0; *(GAS v2u*)(yp + 8) = y1;
    }
}

__device__ __forceinline__ float wave_sum(float v) {
#pragma unroll
    for (int o = 1; o < 64; o <<= 1) v += __shfl_xor(v, o);
    return v;
}
__device__ __forceinline__ void ln_rows(Frame& F) {
    const int gw = F.vcu * NWAVES + F.wave, NGW = F.G * NWAVES;
    f32x4 gm[4], bt[4];
#pragma unroll
    for (int jj = 0; jj < 4; ++jj) { gm[jj] = *((const GAS f32x4*)F.gamma + F.lane + 64 * jj); bt[jj] = *((const GAS f32x4*)F.beta + F.lane + 64 * jj); }
    for (int m = gw; m < MTOK; m += NGW) {
        GAS f32x4* xr = (GAS f32x4*)(F.out + (size_t)m * DM) + F.lane;
        f32x4 v[4]; float s = 0.f;
#pragma unroll
        for (int jj = 0; jj < 4; ++jj) { v[jj] = xr[64 * jj]; s += (v[jj].x + v[jj].y) + (v[jj].z + v[jj].w); }
        const float mean = wave_sum(s) * (1.f / DM); float s2 = 0.f;
#pragma unroll
        for (int jj = 0; jj < 4; ++jj) { v[jj] = v[jj] - mean; s2 += (v[jj].x * v[jj].x + v[jj].y * v[jj].y) + (v[jj].z * v[jj].z + v[jj].w * v[jj].w); }
        const float rstd = 1.f / sqrtf(wave_sum(s2) * (1.f / DM) + LN_EPS);
#pragma unroll
        for (int jj = 0; jj < 4; ++jj) { f32x4 o = v[jj] * rstd * gm[jj] + bt[jj];
#if defined(DIAG) && (DIAG & 4)
            o.x = __uint_as_float(f2bf(o.x) << 16); o.y = __uint_as_float(f2bf(o.y) << 16); o.z = __uint_as_float(f2bf(o.z) << 16); o.w = __uint_as_float(f2bf(o.w) << 16);
#endif
            xr[64 * jj] = o; }
    }
}

struct Args { const float* in[10]; float* out; unsigned char* ws; int ph_lo, ph_hi; };
constexpr int NPHASE = 8;
__global__ void __launch_bounds__(NWAVES * 64, 2) fwd(Args args) {
    extern __shared__ __attribute__((aligned(16))) unsigned char lds[];
    Frame F;
    F.lds = (LAS unsigned char*)lds;
    F.MISC = (volatile LAS unsigned*)(F.lds + MISC_OFF);
    F.tid = threadIdx.x; F.lane = F.tid & 63; F.wave = __builtin_amdgcn_readfirstlane(F.tid >> 6);
    F.G = gridDim.x; { const int bx = blockIdx.x; F.vcu = (F.G % 8 == 0) ? (bx % 8) * (F.G / 8) + bx / 8 : bx; }
    unsigned char* ws = args.ws;
    F.ctl = (gu32*)(ws + WS_CTL);
    F.x = args.in[0]; F.w_in = args.in[1]; F.b_gate = args.in[2]; F.sinks = args.in[3]; F.rel = args.in[4];
    F.w_oa = args.in[5]; F.w_ob = args.in[6]; F.w_out = args.in[7]; F.gamma = args.in[8]; F.beta = args.in[9]; F.out = args.out;
    F.WinT = (bf16*)(ws + WS_WIN); F.WoabT = (bf16*)(ws + WS_WOAB); F.WoutT = (bf16*)(ws + WS_WOUT);
    F.XB = (bf16*)(ws + WS_XB); F.YA = (bf16*)(ws + WS_YA); F.YB = (bf16*)(ws + WS_YB); F.QKZ = (bf16*)(ws + WS_QKZ);
    F.GB = (bf16*)(ws + WS_G); F.VT = (bf16*)(ws + WS_VT); F.MRG = (bf16*)(ws + WS_MRG); F.PO = (bf16*)args.out;
    F.kpart = (float*)(ws + WS_KPART); F.T = (bf16*)(ws + WS_T); F.PML = (float*)(ws + WS_PML); F.SEL = (unsigned*)(ws + WS_SEL);
    for (int u = F.tid; u < (LDS_BYTES - LDSCTL_OFF) / 4; u += NWAVES * 64) ((LAS unsigned*)(F.lds + LDSCTL_OFF))[u] = 0u;
    __syncthreads();
    const int lo = args.ph_lo, hi = args.ph_hi;
    XcdBarrier bar; bar.bar = (unsigned*)(F.ctl + CW_BAR); bar.x = 0; bar.st = nullptr;
    if (hi - lo > 1) bar = xcd_barrier_post((unsigned*)(F.ctl + CW_BAR), F.MISC + 8);
#ifndef PHASE_MASK
#define PHASE_MASK 0xff
#endif
#define IN(k) (((PHASE_MASK >> (k)) & 1) && lo <= (k) && (k) < hi)
#define SEAM(k) do { if (IN(k) && IN((k) + 1)) xcd_barrier(bar); } while (0)

#ifndef REPEAT
#define REPEAT -1
#endif
#define RUN(k, BODY) do { if (IN(k)) { BODY(0); if (REPEAT == (k)) { xcd_barrier(bar); BODY(1); } SEAM(k); } } while (0)
#define P0_BODY(rep) do { p0_prologue(F); } while (0)
#define P1_BODY(rep) do { pg8::Gemm g{F.XB, nullptr, F.WinT, MTOK, NIN, 1024}; pg8::StaticOrder S; S.init(MTOK, NIN, F.G, (int)blockIdx.x); \
        pg8::Epi1 E{F.QKZ, F.GB, F.VT, F.kpart, F.b_gate}; \
        pg8::gemm_phase<pg8::Epi1, pg8::StaticOrder, true, true>(F.lds, g, S, E); } while (0)
#define P2_BODY(rep) do { for (int u = F.vcu; u < 512; u += F.G) { const int bh = u >> 4, uu = (u & 256) ? 15 - (u & 15) : (u & 15); gate_unit(F, bh >> 3, bh & 7, uu); } } while (0)
#define P3_BODY(rep) do { for (;;) { \
            __syncthreads(); \
            if (F.tid == 0) F.MISC[0] = __hip_atomic_fetch_add(F.ctl + CW_Q3 + 64 * (rep), 1u, RLX_AGENT); \
            __syncthreads(); \
            const int id = (int)F.MISC[0]; \
            if (id >= 1280) break; \
            if (id < 512) sel_unit(F, (id & 31) >> 3, id & 7, id >> 5); \
            else if (id < 768) { const int s = id - 512; swa_unit(F, s >> 6, (s >> 5) & 1, s & 31); } \
            else { const int s = id - 256; sel_unit(F, (s & 31) >> 3, s & 7, s >> 5); } } } while (0)
#define P4_BODY(rep) do { merge_rows(F); } while (0)
#define P5_BODY(rep) do { __syncthreads(); \
        pg8::Gemm g{F.YA, F.YB, F.WoabT, MTOK, 2048, 512}; pg8::OrderOut S{F.vcu, F.G}; \
        pg8::EpiOut E{F.GB, F.T, F.MRG}; \
        pg8::gemm_phase<pg8::EpiOut, pg8::OrderOut, true, true>(F.lds, g, S, E); } while (0)
#define P6_BODY(rep) do { pg8::Gemm g{F.MRG, nullptr, F.WoutT, MTOK, 1024, 1024}; pg8::OrderRes S{F.vcu, F.G}; \
        pg8::EpiRes E{F.x, F.out}; \
        pg8::gemm_phase<pg8::EpiRes, pg8::OrderRes, true, true>(F.lds, g, S, E); } while (0)
#define P7_BODY(rep) do { ln_rows(F); } while (0)
    RUN(0, P0_BODY); RUN(1, P1_BODY); RUN(2, P2_BODY); RUN(3, P3_BODY); RUN(4, P4_BODY); RUN(5, P5_BODY); RUN(6, P6_BODY);
    if (IN(7)) { P7_BODY(0); }
#undef IN
#undef SEAM
}

#ifndef N_LAUNCHES
#define N_LAUNCHES 1
#endif
extern "C" void kernel_launch(void* const* d_in, const int* in_sizes, int n_in, void* d_out, int out_size, void* d_ws, size_t ws_size, hipStream_t stream) {
    static int grid = 0;
    if (grid == 0) {
        if (n_in != 10 || in_sizes[0] != MTOK * DM || out_size != MTOK * DM || ws_size < WS_END) {
            fprintf(stderr, "kernel_launch: unexpected shapes (n_in %d, in0 %d, out %d, ws %zu); nothing launched\n", n_in, n_in > 0 ? in_sizes[0] : -1, out_size, ws_size); grid = -1; return; }
        int dev = 0, cus = 0, per_cu = 0;
        if (hipGetDevice(&dev) != hipSuccess || hipDeviceGetAttribute(&cus, hipDeviceAttributeMultiprocessorCount, dev) != hipSuccess) { grid = -1; return; }
        if (hipFuncSetAttribute((const void*)fwd, hipFuncAttributeMaxDynamicSharedMemorySize, LDS_BYTES) != hipSuccess) { fprintf(stderr, "kernel_launch: hipFuncSetAttribute failed\n"); grid = -1; return; }
        if (hipOccupancyMaxActiveBlocksPerMultiprocessor(&per_cu, (const void*)fwd, NWAVES * 64, LDS_BYTES) != hipSuccess || per_cu < 1) { fprintf(stderr, "kernel_launch: occupancy query says %d blocks per CU\n", per_cu); per_cu = 1; }
        (void)hipGetLastError();
        grid = cus;
    }
    if (grid < 0) return;
    (void)hipMemsetAsync((char*)d_ws + WS_CTL, 0, CTL_ZERO_BYTES, stream);
    Args a{};
    for (int i = 0; i < 10; ++i) a.in[i] = (const float*)d_in[i];
    a.out = (float*)d_out; a.ws = (unsigned char*)d_ws;
    for (int li = 0; li < N_LAUNCHES; ++li) {
        a.ph_lo = li * NPHASE / N_LAUNCHES; a.ph_hi = (li + 1) * NPHASE / N_LAUNCHES;
        hipLaunchKernelGGL(fwd, dim3(grid), dim3(NWAVES * 64), LDS_BYTES, stream, a);
    }
}
```
